# Optimizing an MI355X kernel written in HIP

```python
import math
import jax, jax.numpy as jnp
from jax import lax
import numpy as np

D_MODEL = 2048
BATCH = 8
SEQ = 2048
DEPTH = 4

MEM_LEN = 256
HEAD_DIM = 128
A_HEADS = 6
IDX_HEADS = 16
IDX_DIM = 64
TOPK_MAX = 256
B_HEADS = 6
Q_LORA = 512
KV_LORA = 512
NOPE_DIM = 128
ROPE_DIM = 64
V_DIM = 128
ROPE_THETA = 10000.0
C_HEADS = 4
N_BRANCH = 3
REL_BUCKETS = 32
REL_MAX_DIST = 128
D_FF = 5632
Q_BLOCK = 128
LN_EPS = 1e-5
RMS_EPS = 1e-6
DEEPNORM_ALPHA = (2 * DEPTH) ** 0.25
DEEPNORM_BETA = (8 * DEPTH) ** -0.25
A_WIDTH = A_HEADS * HEAD_DIM
B_WIDTH = B_HEADS * V_DIM
C_WIDTH = C_HEADS * HEAD_DIM
MIX_WIDTH = A_WIDTH + B_WIDTH + C_WIDTH
IN_SIZES = (A_WIDTH, HEAD_DIM, HEAD_DIM,
            IDX_HEADS * IDX_DIM, IDX_DIM, IDX_HEADS,
            Q_LORA, KV_LORA, ROPE_DIM,
            C_WIDTH,
            N_BRANCH * D_MODEL)
IN_COLS = sum(IN_SIZES)

kernel_name = 'hybrid_dsa_mla_memory_macaron_deepnorm'


def layer_norm(x, g, b):
    xf = x.astype(jnp.float32)
    mu = jnp.mean(xf, axis=-1, keepdims=True)
    var = jnp.mean(jnp.square(xf - mu), axis=-1, keepdims=True)
    return ((xf - mu) * lax.rsqrt(var + LN_EPS) * g + b).astype(x.dtype)


def rms_norm(x, g):
    xf = x.astype(jnp.float32)
    return (xf * lax.rsqrt(jnp.mean(jnp.square(xf), axis=-1, keepdims=True) + RMS_EPS) * g).astype(x.dtype)


def swiglu(x, w_up, w_down):
    gate, up = jnp.split(x @ w_up, 2, axis=-1)
    return (jax.nn.silu(gate) * up) @ w_down


def rope(x, cos, sin):
    x1, x2 = jnp.split(x, 2, axis=-1)
    cos = cos.astype(x.dtype)
    sin = sin.astype(x.dtype)
    return jnp.concatenate([x1 * cos - x2 * sin, x1 * sin + x2 * cos], axis=-1)


def rel_bucket(dist):
    n = jnp.maximum(dist, 0)
    max_exact = REL_BUCKETS // 2
    nf = jnp.maximum(n, 1).astype(jnp.float32)
    large = max_exact + (jnp.log(nf / max_exact) / math.log(REL_MAX_DIST / max_exact)
                         * (REL_BUCKETS - max_exact)).astype(jnp.int32)
    large = jnp.minimum(large, REL_BUCKETS - 1)
    return jnp.where(n < max_exact, n, large)


_gather_rows = jax.vmap(lambda arr, idx: arr[idx])


def dsa_attention(qa, ka, va, iq, ik, iw, pos, rel_bias):
    B, S = qa.shape[0], qa.shape[1]
    k_sel = min(TOPK_MAX, S // 4)
    n_blk = S // Q_BLOCK
    key_idx = jnp.arange(S)
    scale = HEAD_DIM ** -0.5

    def block(i):
        t0 = i * Q_BLOCK
        q = lax.dynamic_slice_in_dim(qa, t0, Q_BLOCK, axis=1)
        qi = lax.dynamic_slice_in_dim(iq, t0, Q_BLOCK, axis=1)
        wi = lax.dynamic_slice_in_dim(iw, t0, Q_BLOCK, axis=1)
        pq = lax.dynamic_slice_in_dim(pos, t0, Q_BLOCK, axis=1)
        tq = t0 + jnp.arange(Q_BLOCK)
        dots = jnp.einsum('bthd,bsd->bths', qi, ik)
        score = jnp.einsum('bth,bths->bts', wi, jax.nn.relu(dots)).astype(jnp.float32)
        causal = key_idx[None, :] <= tq[:, None]
        score = jnp.where(causal[None], score, -jnp.inf)
        _, sel = lax.top_k(score, k_sel)
        valid = sel <= tq[None, :, None]
        k_g = _gather_rows(ka, sel)
        v_g = _gather_rows(va, sel)
        p_g = _gather_rows(pos, sel)
        logits = jnp.einsum('bthd,btkd->bhtk', q, k_g).astype(jnp.float32) * scale
        bias = rel_bias[rel_bucket(pq[:, :, None] - p_g)]
        logits = logits + jnp.moveaxis(bias, -1, 1).astype(jnp.float32)
        logits = jnp.where(valid[:, None], logits, -jnp.inf)
        p = jax.nn.softmax(logits, axis=-1).astype(v_g.dtype)
        return jnp.einsum('bhtk,btkd->bthd', p, v_g)

    out = lax.map(block, jnp.arange(n_blk))
    return jnp.transpose(out, (1, 0, 2, 3, 4)).reshape(B, S, A_HEADS * HEAD_DIM)


def causal_block_attention(q, k, v, scale):
    B, S, H = q.shape[0], q.shape[1], q.shape[2]
    n_blk = S // Q_BLOCK
    key_idx = jnp.arange(S)

    def block(i):
        t0 = i * Q_BLOCK
        qb = lax.dynamic_slice_in_dim(q, t0, Q_BLOCK, axis=1)
        tq = t0 + jnp.arange(Q_BLOCK)
        logits = jnp.einsum('bthd,bshd->bhts', qb, k).astype(jnp.float32) * scale
        logits = jnp.where((key_idx[None, :] <= tq[:, None])[None, None], logits, -jnp.inf)
        p = jax.nn.softmax(logits, axis=-1).astype(v.dtype)
        return jnp.einsum('bhts,bshd->bthd', p, v)

    out = lax.map(block, jnp.arange(n_blk))
    return jnp.transpose(out, (1, 0, 2, 3, 4)).reshape(B, S, H * v.shape[-1])


def token_mixing(h, mem, pos, cos, sin, rel_bias, w_in, q_norm, kv_norm, w_uq, w_ukv,
                 w_mem_kv, w_branch, w_out):
    B, S, D = h.shape
    splits = [int(c) for c in np.cumsum(IN_SIZES)[:-1]]
    (a_q, a_k, a_v, i_q, i_k, i_w, b_cq, b_ckv, b_kr, c_q, gates) = jnp.split(h @ w_in, splits, axis=-1)

    o_a = dsa_attention(a_q.reshape(B, S, A_HEADS, HEAD_DIM), a_k, a_v,
                        i_q.reshape(B, S, IDX_HEADS, IDX_DIM), i_k,
                        i_w * (IDX_HEADS * IDX_DIM) ** -0.5, pos, rel_bias)

    q = (rms_norm(b_cq, q_norm) @ w_uq).reshape(B, S, B_HEADS, NOPE_DIM + ROPE_DIM)
    q_nope, q_rope = jnp.split(q, [NOPE_DIM], axis=-1)
    q_rope = rope(q_rope, cos[:, :, None, :], sin[:, :, None, :])
    kv = (rms_norm(b_ckv, kv_norm) @ w_ukv).reshape(B, S, B_HEADS, NOPE_DIM + V_DIM)
    k_nope, v_b = jnp.split(kv, [NOPE_DIM], axis=-1)
    k_rope = rope(b_kr, cos, sin)
    k_rope = jnp.broadcast_to(k_rope[:, :, None, :], (B, S, B_HEADS, ROPE_DIM))
    o_b = causal_block_attention(jnp.concatenate([q_nope, q_rope], axis=-1),
                                 jnp.concatenate([k_nope, k_rope], axis=-1),
                                 v_b, (NOPE_DIM + ROPE_DIM) ** -0.5)

    mk, mv = jnp.split((mem @ w_mem_kv).reshape(B, mem.shape[1], 2, C_HEADS, HEAD_DIM), 2, axis=2)
    mk, mv = mk[:, :, 0], mv[:, :, 0]
    logits = jnp.einsum('bthd,bmhd->bhtm', c_q.reshape(B, S, C_HEADS, HEAD_DIM), mk).astype(jnp.float32)
    p = jax.nn.softmax(logits * HEAD_DIM ** -0.5, axis=-1).astype(mv.dtype)
    o_c = jnp.einsum('bhtm,bmhd->bthd', p, mv).reshape(B, S, C_WIDTH)

    y = jnp.stack([o_a @ w_branch[:A_WIDTH],
                   o_b @ w_branch[A_WIDTH:A_WIDTH + B_WIDTH],
                   o_c @ w_branch[A_WIDTH + B_WIDTH:]], axis=-2)
    g = jax.nn.sigmoid(gates.reshape(B, S, N_BRANCH, D))
    return jnp.sum(g * y, axis=-2) @ w_out


def setup_inputs(seed: int = 0) -> dict:
    key = jax.random.key(seed)
    ks = jax.random.split(key, 20)

    def nrm(k, shape, scale):
        return jax.random.normal(k, shape, jnp.float32) * scale

    offset = jax.random.randint(ks[2], (BATCH, 1), 0, 1024, dtype=jnp.int32)
    positions = offset + jnp.arange(SEQ, dtype=jnp.int32)[None, :]
    beta = DEEPNORM_BETA
    return {
        'x': nrm(ks[0], (BATCH, SEQ, D_MODEL), 1.0),
        'mem': nrm(ks[1], (BATCH, MEM_LEN, D_MODEL), 1.0),
        'positions': positions,
        'rel_bias': nrm(ks[3], (REL_BUCKETS, A_HEADS), 0.5),
        'ln_g': 1.0 + nrm(ks[4], (DEPTH, 3, D_MODEL), 0.02),
        'ln_b': nrm(ks[5], (DEPTH, 3, D_MODEL), 0.02),
        'ffn1_up': nrm(ks[6], (DEPTH, D_MODEL, 2 * D_FF), D_MODEL ** -0.5),
        'ffn1_down': nrm(ks[7], (DEPTH, D_FF, D_MODEL), beta * D_FF ** -0.5),
        'w_in': nrm(ks[8], (DEPTH, D_MODEL, IN_COLS), D_MODEL ** -0.5),
        'q_norm': 1.0 + nrm(ks[9], (DEPTH, Q_LORA), 0.02),
        'kv_norm': 1.0 + nrm(ks[10], (DEPTH, KV_LORA), 0.02),
        'w_uq': nrm(ks[11], (DEPTH, Q_LORA, B_HEADS * (NOPE_DIM + ROPE_DIM)), Q_LORA ** -0.5),
        'w_ukv': nrm(ks[12], (DEPTH, KV_LORA, B_HEADS * (NOPE_DIM + V_DIM)), KV_LORA ** -0.5),
        'w_mem_kv': nrm(ks[13], (DEPTH, D_MODEL, 2 * C_WIDTH), D_MODEL ** -0.5),
        'w_branch': nrm(ks[14], (DEPTH, MIX_WIDTH, D_MODEL), beta * HEAD_DIM ** -0.5 * 0.5),
        'w_out': nrm(ks[15], (DEPTH, D_MODEL, D_MODEL), beta * D_MODEL ** -0.5),
        'ffn2_up': nrm(ks[16], (DEPTH, D_MODEL, 2 * D_FF), D_MODEL ** -0.5),
        'ffn2_down': nrm(ks[17], (DEPTH, D_FF, D_MODEL), beta * D_FF ** -0.5),
    }


def reference(x, mem, positions, rel_bias, ln_g, ln_b, ffn1_up, ffn1_down, w_in, q_norm, kv_norm,
              w_uq, w_ukv, w_mem_kv, w_branch, w_out, ffn2_up, ffn2_down):
    inv_freq = ROPE_THETA ** (-jnp.arange(0, ROPE_DIM, 2, dtype=jnp.float32) / ROPE_DIM)
    ang = positions.astype(jnp.float32)[..., None] * inv_freq
    cos, sin = jnp.cos(ang), jnp.sin(ang)
    for l in range(DEPTH):
        x = layer_norm(DEEPNORM_ALPHA * x + 0.5 * swiglu(x, ffn1_up[l], ffn1_down[l]), ln_g[l, 0], ln_b[l, 0])
        mix = token_mixing(x, mem, positions, cos, sin, rel_bias, w_in[l], q_norm[l], kv_norm[l],
                           w_uq[l], w_ukv[l], w_mem_kv[l], w_branch[l], w_out[l])
        x = layer_norm(DEEPNORM_ALPHA * x + mix, ln_g[l, 1], ln_b[l, 1])
        x = layer_norm(DEEPNORM_ALPHA * x + 0.5 * swiglu(x, ffn2_up[l], ffn2_down[l]), ln_g[l, 2], ln_b[l, 2])
    return x
```

```cpp
#include <hip/hip_runtime.h>
#include <cstdio>
#include <cstdint>

#ifndef ONE_LAUNCH
#define ONE_LAUNCH 1
#endif

#define GAS __attribute__((address_space(1)))
#define LAS __attribute__((address_space(3)))
typedef _Float16 half_t;
typedef _Float16 h16x8 __attribute__((ext_vector_type(8)));
typedef _Float16 h16x4 __attribute__((ext_vector_type(4)));
typedef _Float16 h16x2 __attribute__((ext_vector_type(2)));
typedef float f32x4 __attribute__((ext_vector_type(4)));
typedef float f32x2 __attribute__((ext_vector_type(2)));
typedef unsigned u32x4 __attribute__((ext_vector_type(4)));
typedef unsigned u32x2 __attribute__((ext_vector_type(2)));

constexpr int D = 2048, BATCH = 8, SEQ = 2048, M = BATCH * SEQ, DEPTH = 4, MEML = 256, HD = 128;
constexpr int A_HEADS = 6, IDX_HEADS = 16, IDX_DIM = 64, TOPK = 256, B_HEADS = 6, QL = 512, KVL = 512, NOPE = 128, ROPE = 64, VD = 128, C_HEADS = 4;
constexpr int DFF = 5632, IN_COLS = 9872, PROJ_LD = 9984;
constexpr int QB_LD = 1280, KVB_LD = 1536, LATN_LD = 1024;
constexpr float LN_EPS = 1e-5f, RMS_EPS = 1e-6f;
constexpr float ALPHA = 1.681792830507429f;
constexpr int PC_AQ = 0, PC_AK = 768, PC_AV = 896, PC_IQ = 1024, PC_IK = 2048, PC_KR = 2112, PC_IW = 2176, PC_CQL = 2304, PC_CKVL = 2816, PC_CQ = 3328, PC_GATES = 3840;
constexpr int NWAVES = 8, NTHREADS = 512;

constexpr size_t al256(size_t x) { return (x + 255) & ~(size_t)255; }
constexpr size_t WS_CTL = 0, CTL_ZERO_BYTES = 1u << 20;
constexpr size_t SZ_WUP = (size_t)2 * DFF * D * 2, SZ_WDN = (size_t)D * DFF * 2, SZ_WIN = (size_t)PROJ_LD * D * 2, SZ_WUQ = (size_t)QB_LD * QL * 2, SZ_WUKV = (size_t)KVB_LD * KVL * 2;
constexpr size_t SZ_WBR = (size_t)D * D * 2, SZ_WOUT = (size_t)D * D * 2;
constexpr size_t LW_UP1 = 0, LW_DN1 = LW_UP1 + SZ_WUP, LW_IN = LW_DN1 + SZ_WDN, LW_UQ = LW_IN + SZ_WIN, LW_UKV = LW_UQ + SZ_WUQ, LW_BR = LW_UKV + SZ_WUKV, LW_OUT = LW_BR + SZ_WBR,
                 LW_UP2 = LW_OUT + SZ_WOUT, LW_DN2 = LW_UP2 + SZ_WUP, LW_END = LW_DN2 + SZ_WDN;
constexpr size_t WS_W = CTL_ZERO_BYTES;
constexpr size_t WS_WMEM = WS_W + (size_t)DEPTH * LW_END;
constexpr size_t WS_X16 = WS_WMEM + (size_t)DEPTH * 1024 * D * 2;
constexpr size_t WS_R1 = WS_X16 + (size_t)M * D * 2;
constexpr size_t R1_PRELN = (size_t)M * DFF * 2;
constexpr size_t WS_OCAT = WS_R1 + (size_t)M * PROJ_LD * 2;
constexpr size_t WS_QB = WS_OCAT + (size_t)M * D * 2;
constexpr size_t WS_KVB = WS_QB + (size_t)M * QB_LD * 2;
constexpr size_t WS_LATN = WS_KVB + (size_t)M * KVB_LD * 2;
constexpr size_t WS_KROPE = WS_LATN + (size_t)M * LATN_LD * 2;
constexpr size_t WS_TMP = WS_KROPE + (size_t)M * ROPE * 2;
constexpr size_t WS_SEL = WS_TMP + (size_t)M * D * 4;
constexpr size_t WS_CS = WS_SEL + (size_t)M * TOPK * 2;
constexpr size_t WS_MEM16 = WS_CS + (size_t)M * 64 * 4;
constexpr size_t WS_MEMKV = WS_MEM16 + (size_t)BATCH * MEML * D * 2;
constexpr size_t WS_LUT = WS_MEMKV + (size_t)BATCH * MEML * 4096 * 2;
constexpr size_t WS_END = WS_LUT + 1024;
static_assert(R1_PRELN + (size_t)M * D * 4 <= (size_t)M * PROJ_LD * 2, "preLN fits behind h16");
static_assert(WS_W % 256 == 0 && LW_END % 256 == 0, "align");

constexpr int CW_BAR = 4096;

constexpr int RING_BYTES = 131072, LDSCTL_OFF = RING_BYTES, LDS_BYTES = 147456;

#define LDS_WAIT() asm volatile("s_waitcnt lgkmcnt(0)" ::: "memory")
#define VM_WAIT() asm volatile("s_waitcnt vmcnt(0)" ::: "memory")
__device__ __forceinline__ unsigned pkh(float lo, float hi) { h16x2 v; v.x = (half_t)lo; v.y = (half_t)hi; return __builtin_bit_cast(unsigned, v); }
__device__ __forceinline__ float wave_sum(float v) {
#pragma unroll
    for (int o = 1; o < 64; o <<= 1) v += __shfl_xor(v, o);
    return v;
}
__device__ __forceinline__ float wave_max(float v) {
#pragma unroll
    for (int o = 1; o < 64; o <<= 1) v = fmaxf(v, __shfl_xor(v, o));
    return v;
}
__device__ __forceinline__ float fast_sigmoid(float x) { return __builtin_amdgcn_rcpf(1.0f + __builtin_amdgcn_exp2f(-1.4426950408889634f * x)); }

#define XB_TMO      128
#define XB_XCNT(j)  (256  + 64 * (j))
#define XB_XSUB(j)  (1280 + 64 * (j))
#define XB_XGEN(j)  (2304 + 64 * (j))
#define XB_TOP      3328
#define XB_TOPGEN   3392
#define XCD_BAR_WORDS 3456
#define XB_SPIN_CAP (1u << 20)
__device__ __forceinline__ unsigned xb_ld(unsigned* p)              { return __hip_atomic_load(p, __ATOMIC_RELAXED, __HIP_MEMORY_SCOPE_AGENT); }
__device__ __forceinline__ unsigned xb_add(unsigned* p, unsigned v) { return __hip_atomic_fetch_add(p, v, __ATOMIC_RELAXED, __HIP_MEMORY_SCOPE_AGENT); }
__device__ __forceinline__ unsigned xb_xcc_id() { return (unsigned)__builtin_amdgcn_s_getreg((3 << 11) | 20) & 0xFu; }
#define XB_SPIN(cond, bar) do { unsigned _sp = 0; while (cond) { __builtin_amdgcn_s_sleep(1); \
    if ((++_sp & 255u) == 0u) { if (xb_ld(&(bar)[XB_TMO])) break; if (_sp > XB_SPIN_CAP) { atomicAdd(&(bar)[XB_TMO], 1u); break; } } } } while (0)
struct XcdBarrier { unsigned* bar; unsigned x; volatile LAS unsigned* st; };
__device__ __forceinline__ XcdBarrier xcd_barrier_post(unsigned* bar, volatile LAS unsigned* st) {
    XcdBarrier b; b.bar = bar; b.x = xb_xcc_id(); b.st = st;
    if (threadIdx.x == 0) (void)xb_add(&bar[XB_XCNT(b.x)], 1u);
    return b;
}
__device__ __forceinline__ void xcd_barrier_complete(unsigned* bar, unsigned x, unsigned& nloc, unsigned& nx) {
    const unsigned G = gridDim.x * gridDim.y * gridDim.z;
    unsigned sum, cnt, mine, sp = 0u;
    for (;;) {
        sum = 0u; cnt = 0u; mine = 0u;
#pragma unroll
        for (unsigned j = 0; j < 16; ++j) { const unsigned c = xb_ld(&bar[XB_XCNT(j)]); sum += c; cnt += (c > 0u) ? 1u : 0u; mine = (j == x) ? c : mine; }
        if (sum == G) break;
        __builtin_amdgcn_s_sleep(1);
        if ((++sp & 255u) == 0u) { if (xb_ld(&bar[XB_TMO])) break; if (sp > XB_SPIN_CAP) { atomicAdd(&bar[XB_TMO], 1u); break; } }
    }
    nloc = mine > 0u ? mine : 1u; nx = cnt > 0u ? cnt : 1u;
}
__device__ __forceinline__ void xcd_barrier(const XcdBarrier& b) {
    asm volatile("s_waitcnt vmcnt(0)" ::: "memory");
    __syncthreads();
    if (threadIdx.x == 0) {
        unsigned* bar = b.bar;
        __builtin_amdgcn_s_waitcnt(0);
        unsigned nloc = b.st[0], nx = b.st[1];
        if (nloc == 0u) { xcd_barrier_complete(bar, b.x, nloc, nx); b.st[0] = nloc; b.st[1] = nx; }
        const unsigned old = xb_add(&bar[XB_XSUB(b.x)], 1u);
        const unsigned gen = old / nloc;
        if (old + 1u == (gen + 1u) * nloc) {
            __builtin_amdgcn_fence(__ATOMIC_RELEASE, "agent");
            asm volatile("s_waitcnt vmcnt(0)" ::: "memory");
            const unsigned og = xb_add(&bar[XB_TOP], 1u);
            const unsigned tg = og / nx;
            if (og + 1u == (tg + 1u) * nx) xb_add(&bar[XB_TOPGEN], 1u);
            else XB_SPIN(xb_ld(&bar[XB_TOPGEN]) == tg, bar);
            __builtin_amdgcn_fence(__ATOMIC_ACQUIRE, "agent");
            xb_add(&bar[XB_XGEN(b.x)], 1u);
            asm volatile("s_waitcnt vmcnt(0)" ::: "memory");
        } else {
            XB_SPIN(xb_ld(&bar[XB_XGEN(b.x)]) == gen, bar);
            __builtin_amdgcn_fence(__ATOMIC_ACQUIRE, "agent");
            asm volatile("s_waitcnt vmcnt(0)" ::: "memory");
        }
    }
    __syncthreads();
}

namespace pg8 {
constexpr int BM = 256, BK = 64, HALF = 128, HTB = HALF * BK * 2, STAGE_BYTES = 8 * HTB, NXCD = 8, WGM = 8;
__host__ __device__ __forceinline__ int lds_byte(int r, int c) { const int st = (r >> 4) * 2 + (c >> 5), rr = r & 15, cc = c & 31, ob = rr * 64 + cc * 2; return st * 1024 + (ob ^ (((ob >> 9) & 1) << 5)); }
__host__ __device__ __forceinline__ void stage_rc(int b, int& R, int& C) { const int st = b / 1024, sb = b % 1024, swz = sb ^ (((sb >> 9) & 1) << 5); R = (st >> 1) * 16 + swz / 64; C = (st & 1) * 32 + (swz % 64) / 2; }
__host__ __device__ __forceinline__ int perm32(int rho) { const int n = rho >> 4, i = rho & 15; return 8 * (i >> 2) + 4 * n + (i & 3); }
struct Unit { int pm, pn; };
struct Gemm { const half_t* A; const half_t* Bt; int lda, ldb, K; };
struct StaticOrder {
    int nM, nN, nwg, G, c;
    __host__ __device__ void init(int M_, int N_, int G_, int c_) { nM = M_ / BM; nN = N_ / BM; nwg = nM * nN; G = G_; c = c_; }
    __host__ __device__ bool next(int i, Unit& u) const {
        const long L = (long)i * G + c; if (L >= nwg) return false;
        int wgid = (int)L; { const int q = nwg / NXCD, r = nwg % NXCD, xcd = wgid % NXCD, off = wgid / NXCD; wgid = (xcd < r ? xcd * (q + 1) : r * (q + 1) + (xcd - r) * q) + off; }
        const int nig = WGM * nN, gid = wgid / nig, fm = gid * WGM, gsz = (nM - fm) < WGM ? (nM - fm) : WGM;
        u.pm = fm + ((wgid % nig) % gsz); u.pn = (wgid % nig) / gsz; return true;
    }
};
template <class Epi>
__device__ __forceinline__ void gemm_phase(LAS unsigned char* lds, const Gemm g, const StaticOrder& S, const Epi& E) {
    int tid_ = threadIdx.x; asm volatile("" : "+v"(tid_));
    const int tid = tid_, wid = __builtin_amdgcn_readfirstlane(tid >> 6), lane = tid & 63, wr = wid >> 2, wc = wid & 3, fr = lane & 15, fq = lane >> 4;
    const int K = g.K, nt = K / BK;
    unsigned voffA[2], voffB[2];
#pragma unroll
    for (int i = 0; i < 2; ++i) { int R, C; stage_rc(tid * 16 + i * 8192, R, C); const int Rb = Epi::PERM ? ((R & ~31) + perm32(R & 31)) : R;
        voffA[i] = (unsigned)(R * g.lda + C) * 2u; voffB[i] = (unsigned)(Rb * g.ldb + C) * 2u; }
    const size_t kstep = (size_t)(BK * 2);
    const size_t hstepA = (size_t)HALF * g.lda * 2, hstepB = (size_t)HALF * g.ldb * 2;
    const size_t tstepA = 2 * hstepA, tstepB = 2 * hstepB;
    const unsigned ldsw = (unsigned)wid * 1024u;
    const int aoff = lds_byte(wr * 64 + fr, fq * 8), boff = lds_byte(wc * 32 + fr, fq * 8);
#define PG8_SA(b, h) (((b) * 2 + (h)) * HTB)
#define PG8_SB(b, h) ((4 + (b) * 2 + (h)) * HTB)
#define PG8_STAGE(bufoff, gbase, voff) do { _Pragma("unroll") for (int _i = 0; _i < 2; ++_i) \
        __builtin_amdgcn_global_load_lds((const unsigned*)((const char*)(gbase) + (voff)[_i]), (LAS unsigned*)(lds + (bufoff) + ldsw + _i * 8192), 16, 0, 0); } while (0)
#define PG8_LDA(dst, b, h) do { _Pragma("unroll") for (int m = 0; m < 4; ++m) _Pragma("unroll") for (int k = 0; k < 2; ++k) dst[m][k] = *(const LAS h16x8*)(lds + PG8_SA(b, h) + aoff + m * 2048 + k * 1024); } while (0)
#define PG8_LDB(dst, b, h) do { _Pragma("unroll") for (int n = 0; n < 2; ++n) _Pragma("unroll") for (int k = 0; k < 2; ++k) dst[n][k] = *(const LAS h16x8*)(lds + PG8_SB(b, h) + boff + n * 2048 + k * 1024); } while (0)
#define PG8_MMA(ai, bj, At, Bt) do { __builtin_amdgcn_s_setprio(1); _Pragma("unroll") for (int m = 0; m < 4; ++m) _Pragma("unroll") for (int n = 0; n < 2; ++n) _Pragma("unroll") for (int k = 0; k < 2; ++k) \
        acc[ai][bj][m][n] = __builtin_amdgcn_mfma_f32_16x16x32_f16(Bt[n][k], At[m][k], acc[ai][bj][m][n], 0, 0, 0); __builtin_amdgcn_s_setprio(0); } while (0)
#define PG8_WAIT_V(n) asm volatile("s_waitcnt vmcnt(" #n ")" ::: "memory")
#define PG8_WAIT_L(n) asm volatile("s_waitcnt lgkmcnt(" #n ")" ::: "memory")
#define PG8_BAR __builtin_amdgcn_s_barrier()
#define PG8_SCHED __builtin_amdgcn_sched_barrier(0)
    Unit cur, nxt; int ui = 0;
    if (!S.next(0, cur)) return;
    f32x4 acc[2][2][4][2];
#pragma unroll
    for (int a = 0; a < 2; ++a)
#pragma unroll
        for (int b = 0; b < 2; ++b)
#pragma unroll
            for (int m = 0; m < 4; ++m)
#pragma unroll
                for (int n = 0; n < 2; ++n) acc[a][b][m][n] = (f32x4){0.f, 0.f, 0.f, 0.f};
    h16x8 At[4][2], B0[2][2], B1[2][2];
    const char* cA = (const char*)g.A + (size_t)cur.pm * tstepA; const char* cB = (const char*)g.Bt + (size_t)cur.pn * tstepB;
    PG8_STAGE(PG8_SB(0, 0), cB, voffB); PG8_STAGE(PG8_SB(0, 1), cB + hstepB, voffB); PG8_STAGE(PG8_SA(0, 0), cA, voffA); PG8_STAGE(PG8_SA(0, 1), cA + hstepA, voffA);
    if (wr == 1) PG8_BAR;
    PG8_WAIT_V(2); PG8_BAR;
    PG8_STAGE(PG8_SB(1, 0), cB + kstep, voffB); PG8_STAGE(PG8_SA(1, 0), cA + kstep, voffA); PG8_STAGE(PG8_SB(1, 1), cB + hstepB + kstep, voffB);
    PG8_WAIT_V(6); PG8_BAR;
    for (;;) {
        const bool has_next = S.next(ui + 1, nxt);
        const char* nA = has_next ? (const char*)g.A + (size_t)nxt.pm * tstepA : cA; const char* nB = has_next ? (const char*)g.Bt + (size_t)nxt.pn * tstepB : cB;
        for (int t = 0; t < nt; t += 2) {
            const bool last = (t == nt - 2);
            const char* a1 = cA + (size_t)(t + 1) * kstep;
            const char* a2 = last ? nA : cA + (size_t)(t + 2) * kstep; const char* b2 = last ? nB : cB + (size_t)(t + 2) * kstep;
            const char* a3 = a2 + kstep; const char* b3 = b2 + kstep;
            E.mid(acc, cur, t, wr, wc, fr, fq);
            PG8_LDB(B0, 0, 0); PG8_LDB(B1, 0, 1); PG8_SCHED; PG8_LDA(At, 0, 0); PG8_STAGE(PG8_SA(1, 1), a1 + hstepA, voffA);
            PG8_WAIT_V(8); PG8_WAIT_L(0); PG8_BAR; PG8_MMA(0, 0, At, B0); PG8_MMA(0, 1, At, B1); PG8_BAR; PG8_SCHED;
            PG8_LDA(At, 0, 1); PG8_STAGE(PG8_SB(0, 0), b2, voffB); PG8_STAGE(PG8_SB(0, 1), b2 + hstepB, voffB); PG8_STAGE(PG8_SA(0, 0), a2, voffA);
            PG8_WAIT_V(8); PG8_WAIT_L(0); PG8_BAR; PG8_MMA(1, 0, At, B0); PG8_MMA(1, 1, At, B1); PG8_BAR; PG8_SCHED;
            PG8_LDB(B0, 1, 0); PG8_LDB(B1, 1, 1); PG8_SCHED; PG8_LDA(At, 1, 0); PG8_STAGE(PG8_SA(0, 1), a2 + hstepA, voffA);
            PG8_WAIT_V(8); PG8_WAIT_L(0); PG8_BAR; PG8_MMA(0, 0, At, B0); PG8_MMA(0, 1, At, B1); PG8_BAR; PG8_SCHED;
            PG8_LDA(At, 1, 1); PG8_STAGE(PG8_SB(1, 0), b3, voffB); PG8_STAGE(PG8_SB(1, 1), b3 + hstepB, voffB); PG8_STAGE(PG8_SA(1, 0), a3, voffA);
            PG8_WAIT_V(8); PG8_WAIT_L(0); PG8_BAR; PG8_MMA(1, 0, At, B0); PG8_MMA(1, 1, At, B1); PG8_BAR; PG8_SCHED;
        }
        if (wr == 0) PG8_BAR;
        E(acc, cur, wr, wc, fr, fq);
        if (!has_next) break;
#pragma unroll
        for (int a = 0; a < 2; ++a)
#pragma unroll
            for (int b = 0; b < 2; ++b)
#pragma unroll
                for (int m = 0; m < 4; ++m)
#pragma unroll
                    for (int n = 0; n < 2; ++n) acc[a][b][m][n] = (f32x4){0.f, 0.f, 0.f, 0.f};
        cur = nxt; cA = nA; cB = nB; ++ui;
        if (wr == 1) PG8_BAR;
    }
    PG8_WAIT_V(0);
    PG8_BAR;
#undef PG8_SA
#undef PG8_SB
#undef PG8_STAGE
#undef PG8_LDA
#undef PG8_LDB
#undef PG8_MMA
#undef PG8_WAIT_V
#undef PG8_WAIT_L
#undef PG8_BAR
#undef PG8_SCHED
}

typedef f32x4 Acc[2][2][4][2];
struct EpiBase { __device__ __forceinline__ void mid(Acc&, const Unit&, int, int, int, int, int) const {} };
struct EpiSwiglu : EpiBase {
    static constexpr bool PERM = true;
    half_t* H; int ldh;
    __device__ __forceinline__ void operator()(const Acc& acc, const Unit& u, int wr, int wc, int fr, int fq) const {
        const int row0 = u.pm * BM + wr * 64 + fr, col0 = u.pn * 128 + wc * 32 + 8 * fq;
#pragma unroll
        for (int ai = 0; ai < 2; ++ai)
#pragma unroll
            for (int m = 0; m < 4; ++m) {
                half_t* rowp = H + (size_t)(row0 + ai * HALF + m * 16) * ldh + col0;
                float o[8];
#pragma unroll
                for (int n = 0; n < 2; ++n)
#pragma unroll
                    for (int j = 0; j < 4; ++j) { const float gt = acc[ai][0][m][n][j], up = acc[ai][1][m][n][j]; o[n * 4 + j] = gt * fast_sigmoid(gt) * up; }
                u32x4 w; w.x = pkh(o[0], o[1]); w.y = pkh(o[2], o[3]); w.z = pkh(o[4], o[5]); w.w = pkh(o[6], o[7]);
                *(u32x4*)rowp = w;
            }
    }
};
struct EpiResid : EpiBase {
    static constexpr bool PERM = false;
    const float* X; float* O; float alpha, coef;
    __device__ __forceinline__ void operator()(const Acc& acc, const Unit& u, int wr, int wc, int fr, int fq) const {
        const int row0 = u.pm * BM + wr * 64 + fr, col0 = u.pn * BM + wc * 32 + 4 * fq;
#pragma unroll
        for (int ai = 0; ai < 2; ++ai)
#pragma unroll
            for (int m = 0; m < 4; ++m) { const size_t off = (size_t)(row0 + ai * HALF + m * 16) * D + col0;
#pragma unroll
                for (int bj = 0; bj < 2; ++bj)
#pragma unroll
                    for (int n = 0; n < 2; ++n) { const f32x4 xv = *(const f32x4*)(X + off + bj * HALF + n * 16);
                        *(f32x4*)(O + off + bj * HALF + n * 16) = xv * alpha + acc[ai][bj][m][n] * coef; }
                asm volatile("" ::: "memory"); }
    }
};
struct EpiH16 : EpiBase {
    static constexpr bool PERM = true;
    half_t* O; int ldc; int sig_from;
    __device__ __forceinline__ void operator()(const Acc& acc, const Unit& u, int wr, int wc, int fr, int fq) const {
        const int row0 = u.pm * BM + wr * 64 + fr, col0 = u.pn * BM + wc * 32 + 8 * fq;
        const bool sg = u.pn >= sig_from;
#pragma unroll
        for (int ai = 0; ai < 2; ++ai)
#pragma unroll
            for (int m = 0; m < 4; ++m) { half_t* rowp = O + (size_t)(row0 + ai * HALF + m * 16) * ldc + col0;
#pragma unroll
                for (int bj = 0; bj < 2; ++bj) { f32x4 v0 = acc[ai][bj][m][0], v1 = acc[ai][bj][m][1];
                    if (sg) {
#pragma unroll
                        for (int j = 0; j < 4; ++j) { v0[j] = fast_sigmoid(v0[j]); v1[j] = fast_sigmoid(v1[j]); } }
                    u32x4 w; w.x = pkh(v0[0], v0[1]); w.y = pkh(v0[2], v0[3]); w.z = pkh(v1[0], v1[1]); w.w = pkh(v1[2], v1[3]);
                    *(u32x4*)(rowp + bj * HALF) = w; } }
    }
};
template <int MODE> struct EpiBranch : EpiBase {
    static constexpr bool PERM = false;
    const half_t* G; int ldg; float* T; half_t* O;
    __device__ __forceinline__ void operator()(const Acc& acc, const Unit& u, int wr, int wc, int fr, int fq) const {
        const int row0 = u.pm * BM + wr * 64 + fr, col0 = u.pn * BM + wc * 32 + 4 * fq;
#pragma unroll
        for (int ai = 0; ai < 2; ++ai)
#pragma unroll
            for (int m = 0; m < 4; ++m) { const int row = row0 + ai * HALF + m * 16; const size_t off = (size_t)row * D + col0;
#pragma unroll
                for (int bj = 0; bj < 2; ++bj)
#pragma unroll
                    for (int n = 0; n < 2; ++n) { const int co = bj * HALF + n * 16;
                        const h16x4 gv = *(const h16x4*)(G + (size_t)row * ldg + col0 + co);
                        f32x4 v = acc[ai][bj][m][n]; v[0] *= (float)gv[0]; v[1] *= (float)gv[1]; v[2] *= (float)gv[2]; v[3] *= (float)gv[3];
                        if (MODE >= 1) v += *(const f32x4*)(T + off + co);
                        if (MODE <= 1) *(f32x4*)(T + off + co) = v;
                        else { u32x2 w; w.x = pkh(v[0], v[1]); w.y = pkh(v[2], v[3]); *(u32x2*)(O + off + co) = w; } }
                asm volatile("" ::: "memory"); }
    }
};
}

struct Args { const void* in[18]; float* out; unsigned char* ws; int ph_lo, ph_hi; };
struct Frame {
    LAS unsigned char* lds;
    int tid, lane, wave, G, gw, NGW;
    unsigned char* ws;
};

__device__ __forceinline__ int map_col(int kind, int n, float& scale) {
    scale = 1.f;
    if (kind == 0) return n;
    if (kind == 1) { if (n < DFF) return 256 * (n >> 7) + (n & 127); const int q = n - DFF; return 256 * (q >> 7) + 128 + (q & 127); }
    if (n < 2112) return n;
    if (n < 2128) { scale = 1.0f / 32.0f; return n + 64; }
    if (n < 3152) return n + 176;
    if (n < 3216) return n - 1040;
    return n + 112;
}
__device__ __forceinline__ void transpose_item(const float* W, int K, int N, half_t* WT, int kind, LAS float* scr, int item, int lane) {
    const int nblk = (N + 31) / 32, kb = item / nblk, nb = item % nblk, k0 = 64 * kb, n0 = 32 * nb;
    const int nl = (n0 + (lane & 31) < N) ? n0 + (lane & 31) : N - 1;
#pragma unroll 8
    for (int i = 0; i < 32; ++i) { const int kk = 2 * i + (lane >> 5); scr[kk * 33 + (lane & 31)] = W[(size_t)(k0 + kk) * N + nl]; }
    LDS_WAIT(); asm volatile("" ::: "memory");
    const int c = lane & 7;
#pragma unroll
    for (int j = 0; j < 4; ++j) { const int nn = (lane >> 3) + 8 * j; const int n = n0 + nn;
        if (n < N) { float sc; const int dr = map_col(kind, n, sc); const LAS float* s = scr + (8 * c) * 33 + nn;
            u32x4 o; o.x = pkh(s[0 * 33] * sc, s[1 * 33] * sc); o.y = pkh(s[2 * 33] * sc, s[3 * 33] * sc); o.z = pkh(s[4 * 33] * sc, s[5 * 33] * sc); o.w = pkh(s[6 * 33] * sc, s[7 * 33] * sc);
            *(u32x4*)(WT + (size_t)dr * K + k0 + 8 * c) = o; } }
    LDS_WAIT(); asm volatile("" ::: "memory");
}
__device__ __forceinline__ void cvt_f32_to_h16(const float* src, half_t* dst, size_t n8, size_t i0, size_t stride) {
    for (size_t i = i0; i < n8; i += stride) { const f32x4 a = *(const f32x4*)(src + i * 8), b = *(const f32x4*)(src + i * 8 + 4);
        u32x4 o; o.x = pkh(a[0], a[1]); o.y = pkh(a[2], a[3]); o.z = pkh(b[0], b[1]); o.w = pkh(b[2], b[3]); *(u32x4*)(dst + i * 8) = o; }
}

__device__ __forceinline__ void sincos_f32arg(float ang, float& c, float& s) {
    const double x = (double)ang; const double k = __builtin_rint(x * 0.15915494309189535); const double r = x - k * 6.283185307179586; const double r2 = r * r;
    double ts = r, sn = r, tc = 1.0, cn = 1.0;
#pragma unroll 1
    for (int i = 1; i <= 14; ++i) { ts *= -r2 / (double)((2 * i) * (2 * i + 1)); sn += ts; tc *= -r2 / (double)((2 * i - 1) * (2 * i)); cn += tc; }
    c = (float)cn; s = (float)sn;
}
#define PRO_JOB(Wp, Kv, Nv, WTp, kindv) do { const float* _W = (Wp); half_t* _WT = (WTp); const int _nitems = ((Kv) / 64) * (((Nv) + 31) / 32); \
    for (int it = F.gw; it < _nitems; it += F.NGW) transpose_item(_W, (Kv), (Nv), _WT, (kindv), scr, it, F.lane); } while (0)
__device__ __forceinline__ void phase_prologue(const Frame& F0, const Args __attribute__((address_space(4)))* argsp) {
    Frame F = F0; asm volatile("" : "+v"(F.lane)); asm volatile("" : "+s"(F.gw));
#define args (*argsp)
    LAS float* scr = (LAS float*)(F.lds + F.wave * 16384);
    unsigned char* ws = F.ws;
#pragma unroll 1
    for (int l = 0; l < DEPTH; ++l) {
        unsigned char* lw = ws + WS_W + (size_t)l * LW_END;
        PRO_JOB((const float*)args.in[6] + (size_t)l * D * 2 * DFF, D, 2 * DFF, (half_t*)(lw + LW_UP1), 1);
        PRO_JOB((const float*)args.in[7] + (size_t)l * DFF * D, DFF, D, (half_t*)(lw + LW_DN1), 0);
        PRO_JOB((const float*)args.in[8] + (size_t)l * D * IN_COLS, D, IN_COLS, (half_t*)(lw + LW_IN), 2);
        PRO_JOB((const float*)args.in[11] + (size_t)l * QL * 1152, QL, 1152, (half_t*)(lw + LW_UQ), 0);
        PRO_JOB((const float*)args.in[12] + (size_t)l * KVL * 1536, KVL, 1536, (half_t*)(lw + LW_UKV), 0);
        PRO_JOB((const float*)args.in[14] + (size_t)l * D * D, D, D, (half_t*)(lw + LW_BR), 0);
        PRO_JOB((const float*)args.in[15] + (size_t)l * D * D, D, D, (half_t*)(lw + LW_OUT), 0);
        PRO_JOB((const float*)args.in[16] + (size_t)l * D * 2 * DFF, D, 2 * DFF, (half_t*)(lw + LW_UP2), 1);
        PRO_JOB((const float*)args.in[17] + (size_t)l * DFF * D, DFF, D, (half_t*)(lw + LW_DN2), 0);
        PRO_JOB((const float*)args.in[13] + (size_t)l * D * 1024, D, 1024, (half_t*)(ws + WS_WMEM) + (size_t)l * 1024 * D, 0);
        { u32x4 z = {0u, 0u, 0u, 0u}; const size_t gt = (size_t)F.gw * 64 + F.lane, gs = (size_t)F.NGW * 64;
          u32x4* p1 = (u32x4*)((half_t*)(lw + LW_IN) + (size_t)2192 * D); for (size_t i = gt; i < (size_t)112 * D / 8; i += gs) p1[i] = z;
          u32x4* p2 = (u32x4*)((half_t*)(lw + LW_UQ) + (size_t)1152 * QL); for (size_t i = gt; i < (size_t)128 * QL / 8; i += gs) p2[i] = z; }
    }
    const size_t gt = (size_t)F.gw * 64 + F.lane, gs = (size_t)F.NGW * 64;
    cvt_f32_to_h16((const float*)args.in[0], (half_t*)(ws + WS_X16), (size_t)M * D / 8, gt, gs);
    cvt_f32_to_h16((const float*)args.in[1], (half_t*)(ws + WS_MEM16), (size_t)BATCH * MEML * D / 8, gt, gs);
    { const int* pos = (const int*)args.in[2]; float* cs = (float*)(ws + WS_CS);
      for (size_t i = gt; i < (size_t)M * 32; i += gs) { const int m = (int)(i >> 5), f = (int)(i & 31);
          double v = 1.0; for (int q = 0; q < f; ++q) v *= 0.7498942093324559;
          const float inv_freq = (float)v; const float ang = (float)pos[m] * inv_freq; float c, s; sincos_f32arg(ang, c, s);
          cs[(size_t)m * 64 + f] = c; cs[(size_t)m * 64 + 32 + f] = s; } }
    if (F.gw == 0) { int* lut = (int*)(ws + WS_LUT);
#undef args
        for (int n = F.lane; n <= 128; n += 64) { int bkt; if (n < 16) bkt = n; else { const float lg2 = __builtin_amdgcn_logf((float)n * (1.0f / 16.0f)); int lg = 16 + (int)(lg2 * (16.0f / 3.0f)); bkt = lg < 31 ? lg : 31; } lut[n] = bkt; } }
}

__device__ __forceinline__ void phase_ln(const Frame& F0, const float* pre, const float* g, const float* b, float* xout, half_t* x16) {
    Frame F = F0; asm volatile("" : "+v"(F.lane)); asm volatile("" : "+s"(F.gw));
    for (int m = F.gw; m < M; m += F.NGW) {
        const f32x4* xr = (const f32x4*)(pre + (size_t)m * D) + F.lane;
        f32x4 v[8]; float s = 0.f;
#pragma unroll
        for (int j = 0; j < 8; ++j) { v[j] = xr[64 * j]; s += (v[j][0] + v[j][1]) + (v[j][2] + v[j][3]); }
        const float mean = wave_sum(s) * (1.f / D); float s2 = 0.f;
#pragma unroll
        for (int j = 0; j < 8; ++j) { v[j] = v[j] - mean; s2 += (v[j][0] * v[j][0] + v[j][1] * v[j][1]) + (v[j][2] * v[j][2] + v[j][3] * v[j][3]); }
        const float rstd = 1.0f / sqrtf(wave_sum(s2) * (1.f / D) + LN_EPS);
#pragma unroll
        for (int j = 0; j < 8; ++j) { const int c = 4 * (F.lane + 64 * j); const f32x4 gg = *(const f32x4*)(g + c), bb = *(const f32x4*)(b + c);
            const f32x4 o = v[j] * rstd * gg + bb;
            *(f32x4*)(xout + (size_t)m * D + c) = o;
            u32x2 w; w.x = pkh(o[0], o[1]); w.y = pkh(o[2], o[3]); *(u32x2*)(x16 + (size_t)m * D + c) = w; }
    }
}

__device__ __forceinline__ unsigned sortable(float f) { f = f + 0.0f; unsigned u = __builtin_bit_cast(unsigned, f); return (u & 0x80000000u) ? ~u : (u | 0x80000000u); }
__device__ __forceinline__ void phase_p5(const Frame& F0, const half_t* proj, const float* qn, const float* kvn, half_t* latn, half_t* krope, const float* cs, unsigned short* sel) {
    Frame F = F0; asm volatile("" : "+v"(F.lane)); asm volatile("" : "+s"(F.gw));
    for (int m = F.gw; m < M; m += F.NGW) {
        const half_t* pr = proj + (size_t)m * PROJ_LD;
#pragma unroll
        for (int w = 0; w < 2; ++w) {
            const h16x8 v = *(const h16x8*)(pr + (w ? PC_CKVL : PC_CQL) + 8 * F.lane);
            float f[8], s = 0.f;
#pragma unroll
            for (int j = 0; j < 8; ++j) { f[j] = (float)v[j]; s += f[j] * f[j]; }
            const float r = 1.0f / sqrtf(wave_sum(s) * (1.f / 512.f) + RMS_EPS);
            const float* gp = (w ? kvn : qn) + 8 * F.lane;
            u32x4 o; o.x = pkh(f[0] * r * gp[0], f[1] * r * gp[1]); o.y = pkh(f[2] * r * gp[2], f[3] * r * gp[3]); o.z = pkh(f[4] * r * gp[4], f[5] * r * gp[5]); o.w = pkh(f[6] * r * gp[6], f[7] * r * gp[7]);
            *(u32x4*)(latn + (size_t)m * LATN_LD + w * 512 + 8 * F.lane) = o;
        }
        if (F.lane < 32) { const float x1 = (float)pr[PC_KR + F.lane], x2 = (float)pr[PC_KR + 32 + F.lane]; const float c = cs[(size_t)m * 64 + F.lane], s = cs[(size_t)m * 64 + 32 + F.lane];
            krope[(size_t)m * ROPE + F.lane] = (half_t)(x1 * c - x2 * s); krope[(size_t)m * ROPE + 32 + F.lane] = (half_t)(x1 * s + x2 * c); }
    }
    LAS unsigned char* wl = F.lds + F.wave * 12288;
    LAS half_t* iq_l = (LAS half_t*)wl; LAS float* w_l = (LAS float*)(wl + 2048); LAS float* sc_l = (LAS float*)(wl + 4096);
    for (int m = F.gw; m < M; m += F.NGW) {
        const int b = m / SEQ, t = m % SEQ; const int nk = t + 1;
        unsigned short* so = sel + (size_t)m * TOPK;
        if (nk <= TOPK) {
            for (int j = F.lane; j < TOPK; j += 64) so[j] = (unsigned short)(j < nk ? j : 0);
            continue;
        }
        const half_t* pr = proj + (size_t)m * PROJ_LD;
        { const u32x4 a = *(const u32x4*)(pr + PC_IQ + 16 * F.lane), c = *(const u32x4*)(pr + PC_IQ + 16 * F.lane + 8);
          *(LAS u32x4*)(iq_l + 16 * F.lane) = a; *(LAS u32x4*)(iq_l + 16 * F.lane + 8) = c;
          if (F.lane < 16) w_l[F.lane] = (float)pr[PC_IW + F.lane]; }
        LDS_WAIT(); asm volatile("" ::: "memory");
        const int npass = (nk + 63) / 64;
        for (int p = 0; p < npass; ++p) {
            const int s = p * 64 + F.lane; const int sr = s < nk ? s : t;
            const half_t* kp = proj + (size_t)(b * SEQ + sr) * PROJ_LD + PC_IK;
            h16x8 kv[8];
#pragma unroll
            for (int j = 0; j < 8; ++j) kv[j] = *(const h16x8*)(kp + 8 * j);
            float score = 0.f;
#pragma unroll 4
            for (int h = 0; h < IDX_HEADS; ++h) {
                float d = 0.f;
#pragma unroll
                for (int j = 0; j < 8; ++j) { const h16x8 qv = *(const LAS h16x8*)(iq_l + h * 64 + 8 * j);
#pragma unroll
                    for (int e = 0; e < 4; ++e) { h16x2 qa, ka; qa.x = qv[2 * e]; qa.y = qv[2 * e + 1]; ka.x = kv[j][2 * e]; ka.y = kv[j][2 * e + 1]; d = __builtin_amdgcn_fdot2(qa, ka, d, false); } }
                score += w_l[h] * fmaxf(d, 0.f);
            }
            sc_l[s] = score;
        }
        LDS_WAIT(); asm volatile("" ::: "memory");
        unsigned u[32];
#pragma unroll
        for (int j = 0; j < 32; ++j) { const int s = 64 * j + F.lane; u[j] = (s < nk) ? sortable(sc_l[s]) : 0u; }
        unsigned prefix = 0u;
        for (int bit = 31; bit >= 0; --bit) { const unsigned cand = prefix | (1u << bit); int cnt = 0;
#pragma unroll
            for (int j = 0; j < 32; ++j) cnt += __popcll(__ballot(u[j] >= cand));
            if (cnt >= TOPK) prefix = cand; }
        int cgt = 0;
#pragma unroll
        for (int j = 0; j < 32; ++j) cgt += __popcll(__ballot(u[j] > prefix));
        int need = TOPK - cgt;
        int pos = 0;
        const unsigned long long lt_mask = (1ull << F.lane) - 1ull;
#pragma unroll
        for (int j = 0; j < 32; ++j) {
            const unsigned long long beq = __ballot(u[j] == prefix);
            const int rank_eq = __popcll(beq & lt_mask);
            const bool pick = (u[j] > prefix) || (u[j] == prefix && rank_eq < need);
            const unsigned long long bp = __ballot(pick);
            if (pick) so[pos + __popcll(bp & lt_mask)] = (unsigned short)(64 * j + F.lane);
            pos += __popcll(bp);
            const int neq = __popcll(beq); need = need > neq ? need - neq : 0;
        }
        asm volatile("" ::: "memory");
    }
}

template <int NH, bool IS_A>
__device__ __forceinline__ void phase_gattn(const Frame& F0, const half_t* proj, const half_t* memkv, const unsigned short* sel, const int* pos, const float* relb, const int* lut, half_t* ocat) {
    Frame F = F0; asm volatile("" : "+v"(F.lane)); asm volatile("" : "+s"(F.gw));
    LAS unsigned char* wl = F.lds + F.wave * 16384;
    LAS half_t* q_l = (LAS half_t*)wl;
    LAS float* p_l = (LAS float*)(wl + 2048);
    LAS unsigned* idx_l = (LAS unsigned*)(wl + 2048 + 8192);
    LAS float* rb_l = (LAS float*)(wl + 2048 + 8192 + 1024);
    const float scale = 0.08838834764831845f;
    if (IS_A) { for (int i = F.lane; i < 32 * 8; i += 64) rb_l[i] = ((i & 7) < A_HEADS) ? relb[(i >> 3) * A_HEADS + (i & 7)] : 0.f; }
    for (int m = F.gw; m < M; m += F.NGW) {
        const int b = m / SEQ, t = m % SEQ;
        const int nk = IS_A ? (t + 1 < TOPK ? t + 1 : TOPK) : MEML;
        const half_t* qp = proj + (size_t)m * PROJ_LD + (IS_A ? PC_AQ : PC_CQ);
        for (int i = F.lane; i < NH * 16; i += 64) *(LAS u32x4*)(q_l + 8 * i) = *(const u32x4*)(qp + 8 * i);
        for (int j = F.lane; j < 256; j += 64) idx_l[j] = IS_A ? (unsigned)(b * SEQ + sel[(size_t)m * TOPK + j]) : (unsigned)(b * MEML + j);
        LDS_WAIT(); asm volatile("" ::: "memory");
        const int pq = IS_A ? pos[m] : 0;
        float lg[4][NH];
#pragma unroll
        for (int i = 0; i < 4; ++i) {
            const int j = i * 64 + F.lane; const bool valid = j < nk; const unsigned row = idx_l[valid ? j : 0];
            float bias[NH];
#pragma unroll
            for (int h = 0; h < NH; ++h) bias[h] = 0.f;
            if (IS_A) { int dist = pq - pos[row]; dist = dist < 0 ? 0 : (dist > 128 ? 128 : dist); const int bk = lut[dist];
#pragma unroll
                for (int h = 0; h < NH; ++h) bias[h] = rb_l[bk * 8 + h]; }
            if (IS_A) {
                const half_t* kp = proj + (size_t)row * PROJ_LD + PC_AK;
                float d[NH];
#pragma unroll
                for (int h = 0; h < NH; ++h) d[h] = 0.f;
#pragma unroll 4
                for (int c = 0; c < 16; ++c) { const h16x8 kv = *(const h16x8*)(kp + 8 * c);
#pragma unroll
                    for (int h = 0; h < NH; ++h) { const h16x8 qv = *(const LAS h16x8*)(q_l + h * 128 + 8 * c);
#pragma unroll
                        for (int e = 0; e < 4; ++e) { h16x2 qa, ka; qa.x = qv[2 * e]; qa.y = qv[2 * e + 1]; ka.x = kv[2 * e]; ka.y = kv[2 * e + 1]; d[h] = __builtin_amdgcn_fdot2(qa, ka, d[h], false); } } }
#pragma unroll
                for (int h = 0; h < NH; ++h) lg[i][h] = valid ? d[h] * scale + bias[h] : -INFINITY;
            } else {
#pragma unroll
                for (int h = 0; h < NH; ++h) { const half_t* kp = memkv + (size_t)row * 4096 + h * 128; float d = 0.f;
#pragma unroll 4
                    for (int c = 0; c < 16; ++c) { const h16x8 kv = *(const h16x8*)(kp + 8 * c); const h16x8 qv = *(const LAS h16x8*)(q_l + h * 128 + 8 * c);
#pragma unroll
                        for (int e = 0; e < 4; ++e) { h16x2 qa, ka; qa.x = qv[2 * e]; qa.y = qv[2 * e + 1]; ka.x = kv[2 * e]; ka.y = kv[2 * e + 1]; d = __builtin_amdgcn_fdot2(qa, ka, d, false); } }
                    lg[i][h] = valid ? d * scale : -INFINITY; }
            }
        }
#pragma unroll
        for (int h = 0; h < NH; ++h) {
            float mx = fmaxf(fmaxf(lg[0][h], lg[1][h]), fmaxf(lg[2][h], lg[3][h])); mx = wave_max(mx);
            float e[4], s = 0.f;
#pragma unroll
            for (int i = 0; i < 4; ++i) { e[i] = __expf(lg[i][h] - mx); s += e[i]; }
            s = wave_sum(s); const float inv = 1.0f / s;
#pragma unroll
            for (int i = 0; i < 4; ++i) p_l[(i * 64 + F.lane) * 8 + h] = e[i] * inv;
        }
        LDS_WAIT(); asm volatile("" ::: "memory");
        float o[NH][2];
#pragma unroll
        for (int h = 0; h < NH; ++h) { o[h][0] = 0.f; o[h][1] = 0.f; }
#pragma unroll 4
        for (int j = 0; j < nk; ++j) {
            const unsigned row = __builtin_amdgcn_readfirstlane(idx_l[j]);
            const f32x4 p0 = *(const LAS f32x4*)(p_l + j * 8), p1 = *(const LAS f32x4*)(p_l + j * 8 + 4);
            const float pp[8] = {p0[0], p0[1], p0[2], p0[3], p1[0], p1[1], p1[2], p1[3]};
            if (IS_A) { const h16x2 v = *(const h16x2*)(proj + (size_t)row * PROJ_LD + PC_AV + 2 * F.lane); const float v0 = (float)v.x, v1 = (float)v.y;
#pragma unroll
                for (int h = 0; h < NH; ++h) { o[h][0] += pp[h] * v0; o[h][1] += pp[h] * v1; } }
            else {
#pragma unroll
                for (int h = 0; h < NH; ++h) { const h16x2 v = *(const h16x2*)(memkv + (size_t)row * 4096 + 512 + h * 128 + 2 * F.lane); o[h][0] += pp[h] * (float)v.x; o[h][1] += pp[h] * (float)v.y; } }
        }
        half_t* op = ocat + (size_t)m * D + (IS_A ? 0 : 1536);
#pragma unroll
        for (int h = 0; h < NH; ++h) *(unsigned*)(op + h * 128 + 2 * F.lane) = pkh(o[h][0], o[h][1]);
        asm volatile("" ::: "memory");
    }
}

__device__ __forceinline__ void phase_battn(const Frame& F0, const half_t* qb, const half_t* kvb, const half_t* krope, const float* cs, half_t* ocat) {
    Frame F = F0; asm volatile("" : "+v"(F.lane)); asm volatile("" : "+v"(F.tid)); asm volatile("" : "+s"(F.wave));
    constexpr int KROW = 200;
    LAS half_t* k_l = (LAS half_t*)F.lds;
    LAS half_t* v_l = (LAS half_t*)(F.lds + 25600);
    LAS half_t* q_l = (LAS half_t*)(F.lds + 25600 + 16384) + F.wave * 192;
    const float scale = 0.07216878364870322f;
    const int ntask = BATCH * B_HEADS * (SEQ / 8);
    for (int task = blockIdx.x; task < ntask; task += F.G) {
        const int tt = (SEQ / 8 - 1) - task / (BATCH * B_HEADS); const int bh = task % (BATCH * B_HEADS); const int b = bh / B_HEADS, h = bh % B_HEADS;
        const int t = tt * 8 + F.wave, m = b * SEQ + t;
        { const half_t* qp = qb + (size_t)m * QB_LD + h * 192;
          for (int i = F.lane; i < 128; i += 64) q_l[i] = qp[i];
          if (F.lane < 32) { const float x1 = (float)qp[128 + F.lane], x2 = (float)qp[160 + F.lane]; const float c = cs[(size_t)m * 64 + F.lane], s = cs[(size_t)m * 64 + 32 + F.lane];
              q_l[128 + F.lane] = (half_t)(x1 * c - x2 * s); q_l[160 + F.lane] = (half_t)(x1 * s + x2 * c); } }
        float mx = -INFINITY, l = 0.f, o0 = 0.f, o1 = 0.f;
        const int nchunk = (tt * 8 + 8 + 63) / 64;
        for (int c = 0; c < nchunk; ++c) {
            __syncthreads();
            for (int i = F.tid; i < 64 * 24; i += NTHREADS) { const int r = i / 24, pc = i % 24; const int row = b * SEQ + c * 64 + r;
                const u32x4 v = (pc < 16) ? *(const u32x4*)(kvb + (size_t)row * KVB_LD + h * 256 + 8 * pc) : *(const u32x4*)(krope + (size_t)row * ROPE + 8 * (pc - 16));
                *(LAS u32x4*)(k_l + r * KROW + 8 * pc) = v; }
            for (int i = F.tid; i < 64 * 16; i += NTHREADS) { const int r = i / 16, pc = i % 16; const int row = b * SEQ + c * 64 + r;
                *(LAS u32x4*)(v_l + r * 128 + 8 * pc) = *(const u32x4*)(kvb + (size_t)row * KVB_LD + h * 256 + 128 + 8 * pc); }
            __syncthreads();
            const int s = c * 64 + F.lane; const bool valid = s <= t;
            float d = 0.f;
#pragma unroll 6
            for (int pc = 0; pc < 24; ++pc) { const h16x8 kv = *(const LAS h16x8*)(k_l + F.lane * KROW + 8 * pc); const h16x8 qv = *(const LAS h16x8*)(q_l + 8 * pc);
#pragma unroll
                for (int e = 0; e < 4; ++e) { h16x2 qa, ka; qa.x = qv[2 * e]; qa.y = qv[2 * e + 1]; ka.x = kv[2 * e]; ka.y = kv[2 * e + 1]; d = __builtin_amdgcn_fdot2(qa, ka, d, false); } }
            const float lgt = valid ? d * scale : -INFINITY;
            const float mn = fmaxf(mx, wave_max(lgt));
            const float corr = __expf(mx - mn); const float p = __expf(lgt - mn);
            l = l * corr + wave_sum(p); o0 *= corr; o1 *= corr; mx = mn;
#pragma unroll 8
            for (int j = 0; j < 64; ++j) { const float pj = __shfl(p, j); const h16x2 v = *(const LAS h16x2*)(v_l + j * 128 + 2 * F.lane); o0 += pj * (float)v.x; o1 += pj * (float)v.y; }
        }
        const float inv = 1.0f / l;
        *(unsigned*)(ocat + (size_t)m * D + 768 + h * 128 + 2 * F.lane) = pkh(o0 * inv, o1 * inv);
    }
    __syncthreads();
}

constexpr int NP = 13, NPH = 2 + DEPTH * NP;
typedef const Args __attribute__((address_space(4))) CArgs;
#define SITE_PTRS() CArgs* ap = kap; asm volatile("" : "+s"(ap)); unsigned char* ws = ap->ws; (void)ws
__global__ void __launch_bounds__(NTHREADS, 2) fwd_kernel(Args args) {
    extern __shared__ __attribute__((aligned(16))) unsigned char lds_raw[];
    CArgs* kap = (CArgs*)__builtin_amdgcn_kernarg_segment_ptr();
    Frame F;
    F.lds = (LAS unsigned char*)lds_raw;
    F.tid = threadIdx.x; F.lane = F.tid & 63; F.wave = __builtin_amdgcn_readfirstlane(F.tid >> 6);
    F.G = gridDim.x; F.gw = blockIdx.x * NWAVES + F.wave; F.NGW = F.G * NWAVES; F.ws = nullptr;
    volatile LAS unsigned* ctl_l = (volatile LAS unsigned*)(F.lds + LDSCTL_OFF);
    for (int u = F.tid; u < (LDS_BYTES - LDSCTL_OFF) / 4; u += NTHREADS) ctl_l[u] = 0u;
    __syncthreads();
    const int lo = args.ph_lo, hi = args.ph_hi;
    XcdBarrier bar; bar.bar = (unsigned*)(args.ws + WS_CTL) + CW_BAR; bar.x = 0; bar.st = ctl_l + 8;
    if (hi - lo > 1) bar = xcd_barrier_post((unsigned*)(args.ws + WS_CTL) + CW_BAR, ctl_l + 8);
#define IN(k) (lo <= (k) && (k) < hi)
#define SEAM(k) do { if (IN((k) + 1)) xcd_barrier(bar); } while (0)
#define P_X16 ((half_t*)(ws + WS_X16))
#define P_PROJ ((half_t*)(ws + WS_R1))
#define P_H16 ((half_t*)(ws + WS_R1))
#define P_PRELN ((float*)(ws + WS_R1 + R1_PRELN))
#define P_OCAT ((half_t*)(ws + WS_OCAT))
#define P_QB ((half_t*)(ws + WS_QB))
#define P_KVB ((half_t*)(ws + WS_KVB))
#define P_LATN ((half_t*)(ws + WS_LATN))
#define P_KROPE ((half_t*)(ws + WS_KROPE))
#define P_TMPF ((float*)(ws + WS_TMP))
#define P_SEL ((unsigned short*)(ws + WS_SEL))
#define P_CS ((const float*)(ws + WS_CS))
#define P_MEMKV ((half_t*)(ws + WS_MEMKV))
#define P_LUT ((const int*)(ws + WS_LUT))
#define P_LW (ws + WS_W + (size_t)l * LW_END)

#ifndef NO_PRO
    if (IN(0)) { SITE_PTRS(); F.ws = ws; phase_prologue(F, ap); SEAM(0); }
#endif
    if (IN(1)) {
        SITE_PTRS();
        pg8::Gemm g{(const half_t*)(ws + WS_MEM16), (const half_t*)(ws + WS_WMEM), D, D, D}; pg8::StaticOrder S; S.init(BATCH * MEML, 4096, F.G, (int)blockIdx.x);
        pg8::EpiH16 E; E.O = P_MEMKV; E.ldc = 4096; E.sig_from = 1 << 30;
        pg8::gemm_phase(F.lds, g, S, E);
        SEAM(1);
    }
#pragma unroll 1
    for (int l = 0; l < DEPTH; ++l) {
        const int p0 = 2 + l * NP;
        if (p0 + NP <= lo || p0 >= hi) continue;
        if (IN(p0 + 0)) {
            SITE_PTRS();
            pg8::Gemm g{P_X16, (const half_t*)(P_LW + LW_UP1), D, D, D}; pg8::StaticOrder S; S.init(M, 2 * DFF, F.G, (int)blockIdx.x);
            pg8::EpiSwiglu E; E.H = P_H16; E.ldh = DFF;
            pg8::gemm_phase(F.lds, g, S, E); SEAM(p0 + 0);
        }
        if (IN(p0 + 1)) {
            SITE_PTRS();
            pg8::Gemm g{P_H16, (const half_t*)(P_LW + LW_DN1), DFF, DFF, DFF}; pg8::StaticOrder S; S.init(M, D, F.G, (int)blockIdx.x);
            pg8::EpiResid E; E.X = (l == 0) ? (const float*)ap->in[0] : ap->out; E.O = P_PRELN; E.alpha = ALPHA; E.coef = 0.5f;
            pg8::gemm_phase(F.lds, g, S, E); SEAM(p0 + 1);
        }
        if (IN(p0 + 2)) { SITE_PTRS(); phase_ln(F, P_PRELN, (const float*)ap->in[4] + (size_t)l * 3 * D, (const float*)ap->in[5] + (size_t)l * 3 * D, ap->out, P_X16); SEAM(p0 + 2); }
        if (IN(p0 + 3)) {
            SITE_PTRS();
            pg8::Gemm g{P_X16, (const half_t*)(P_LW + LW_IN), D, D, D}; pg8::StaticOrder S; S.init(M, PROJ_LD, F.G, (int)blockIdx.x);
            pg8::EpiH16 E; E.O = P_PROJ; E.ldc = PROJ_LD; E.sig_from = PC_GATES / 256;
            pg8::gemm_phase(F.lds, g, S, E); SEAM(p0 + 3);
        }
        if (IN(p0 + 4)) {
            SITE_PTRS();
#ifndef NO_P5
            phase_p5(F, P_PROJ, (const float*)ap->in[9] + (size_t)l * QL, (const float*)ap->in[10] + (size_t)l * KVL, P_LATN, P_KROPE, P_CS, P_SEL);
#endif
            SEAM(p0 + 4);
        }
        if (IN(p0 + 5)) {
            { SITE_PTRS(); pg8::Gemm g{P_LATN, (const half_t*)(P_LW + LW_UQ), LATN_LD, QL, QL}; pg8::StaticOrder S; S.init(M, QB_LD, F.G, (int)blockIdx.x);
              pg8::EpiH16 E; E.O = P_QB; E.ldc = QB_LD; E.sig_from = 1 << 30; pg8::gemm_phase(F.lds, g, S, E); }
            { SITE_PTRS(); pg8::Gemm g{P_LATN + 512, (const half_t*)(P_LW + LW_UKV), LATN_LD, KVL, KVL}; pg8::StaticOrder S; S.init(M, KVB_LD, F.G, (int)blockIdx.x);
              pg8::EpiH16 E; E.O = P_KVB; E.ldc = KVB_LD; E.sig_from = 1 << 30; pg8::gemm_phase(F.lds, g, S, E); }
            SEAM(p0 + 5);
        }
        if (IN(p0 + 6)) {
#ifndef NO_GA
            { SITE_PTRS(); phase_gattn<A_HEADS, true>(F, P_PROJ, P_MEMKV, P_SEL, (const int*)ap->in[2], (const float*)ap->in[3], P_LUT, P_OCAT); }
#endif
#ifndef NO_GC
            { SITE_PTRS(); phase_gattn<C_HEADS, false>(F, P_PROJ, P_MEMKV + (size_t)l * 1024, P_SEL, (const int*)ap->in[2], (const float*)ap->in[3], P_LUT, P_OCAT); }
#endif
            __syncthreads();
#ifndef NO_BA
            { SITE_PTRS(); phase_battn(F, P_QB, P_KVB, P_KROPE, P_CS, P_OCAT); }
#endif
            SEAM(p0 + 6);
        }
        if (IN(p0 + 7)) {
            { SITE_PTRS(); pg8::Gemm g{P_OCAT, (const half_t*)(P_LW + LW_BR), D, D, 768}; pg8::StaticOrder S; S.init(M, D, F.G, (int)blockIdx.x);
              pg8::EpiBranch<0> E; E.G = P_PROJ + PC_GATES; E.ldg = PROJ_LD; E.T = P_TMPF; E.O = P_X16; pg8::gemm_phase(F.lds, g, S, E); }
            { SITE_PTRS(); pg8::Gemm g{P_OCAT + 768, (const half_t*)(P_LW + LW_BR) + 768, D, D, 768}; pg8::StaticOrder S; S.init(M, D, F.G, (int)blockIdx.x);
              pg8::EpiBranch<1> E; E.G = P_PROJ + PC_GATES + D; E.ldg = PROJ_LD; E.T = P_TMPF; E.O = P_X16; pg8::gemm_phase(F.lds, g, S, E); }
            { SITE_PTRS(); pg8::Gemm g{P_OCAT + 1536, (const half_t*)(P_LW + LW_BR) + 1536, D, D, 512}; pg8::StaticOrder S; S.init(M, D, F.G, (int)blockIdx.x);
              pg8::EpiBranch<2> E; E.G = P_PROJ + PC_GATES + 2 * D; E.ldg = PROJ_LD; E.T = P_TMPF; E.O = P_X16; pg8::gemm_phase(F.lds, g, S, E); }
            SEAM(p0 + 7);
        }
        if (IN(p0 + 8)) {
            SITE_PTRS();
            pg8::Gemm g{P_X16, (const half_t*)(P_LW + LW_OUT), D, D, D}; pg8::StaticOrder S; S.init(M, D, F.G, (int)blockIdx.x);
            pg8::EpiResid E; E.X = ap->out; E.O = P_PRELN; E.alpha = ALPHA; E.coef = 1.0f;
            pg8::gemm_phase(F.lds, g, S, E); SEAM(p0 + 8);
        }
        if (IN(p0 + 9)) { SITE_PTRS(); phase_ln(F, P_PRELN, (const float*)ap->in[4] + (size_t)l * 3 * D + D, (const float*)ap->in[5] + (size_t)l * 3 * D + D, ap->out, P_X16); SEAM(p0 + 9); }
        if (IN(p0 + 10)) {
            SITE_PTRS();
            pg8::Gemm g{P_X16, (const half_t*)(P_LW + LW_UP2), D, D, D}; pg8::StaticOrder S; S.init(M, 2 * DFF, F.G, (int)blockIdx.x);
            pg8::EpiSwiglu E; E.H = P_H16; E.ldh = DFF;
            pg8::gemm_phase(F.lds, g, S, E); SEAM(p0 + 10);
        }
        if (IN(p0 + 11)) {
            SITE_PTRS();
            pg8::Gemm g{P_H16, (const half_t*)(P_LW + LW_DN2), DFF, DFF, DFF}; pg8::StaticOrder S; S.init(M, D, F.G, (int)blockIdx.x);
            pg8::EpiResid E; E.X = ap->out; E.O = P_PRELN; E.alpha = ALPHA; E.coef = 0.5f;
            pg8::gemm_phase(F.lds, g, S, E); SEAM(p0 + 11);
        }
        if (IN(p0 + 12)) { SITE_PTRS(); phase_ln(F, P_PRELN, (const float*)ap->in[4] + (size_t)l * 3 * D + 2 * D, (const float*)ap->in[5] + (size_t)l * 3 * D + 2 * D, ap->out, P_X16); SEAM(p0 + 12); }
    }
#undef IN
#undef SEAM
}

extern "C" void kernel_launch(void* const* d_in, const int* in_sizes, int n_in, void* d_out, int out_size, void* d_ws, size_t ws_size, hipStream_t stream) {
    static int grid = 0;
    if (grid == 0) {
        if (n_in != 18 || out_size != M * D || ws_size < WS_END) { fprintf(stderr, "kernel_launch: unexpected shapes (n_in %d out %d ws %zu need %zu)\n", n_in, out_size, ws_size, (size_t)WS_END); grid = -1; return; }
        int dev = 0, cus = 0, per_cu = 0;
        if (hipGetDevice(&dev) != hipSuccess || hipDeviceGetAttribute(&cus, hipDeviceAttributeMultiprocessorCount, dev) != hipSuccess) { grid = -1; return; }
        if (hipFuncSetAttribute((const void*)fwd_kernel, hipFuncAttributeMaxDynamicSharedMemorySize, LDS_BYTES) != hipSuccess) { fprintf(stderr, "kernel_launch: hipFuncSetAttribute failed\n"); grid = -1; return; }
        if (hipOccupancyMaxActiveBlocksPerMultiprocessor(&per_cu, (const void*)fwd_kernel, NTHREADS, LDS_BYTES) != hipSuccess || per_cu < 1) { fprintf(stderr, "kernel_launch: occupancy query says %d\n", per_cu); }
        (void)hipGetLastError();
        grid = cus;
    }
    if (grid < 0) return;
    (void)hipMemsetAsync((char*)d_ws + WS_CTL, 0, CTL_ZERO_BYTES, stream);
    Args a{};
    for (int i = 0; i < 18; ++i) a.in[i] = d_in[i];
    a.out = (float*)d_out; a.ws = (unsigned char*)d_ws;
#if ONE_LAUNCH
    a.ph_lo = 0; a.ph_hi = NPH;
    hipLaunchKernelGGL(fwd_kernel, dim3(grid), dim3(NTHREADS), LDS_BYTES, stream, a);
#else
    for (int p = 0; p < NPH; ++p) { a.ph_lo = p; a.ph_hi = p + 1; hipLaunchKernelGGL(fwd_kernel, dim3(grid), dim3(NTHREADS), LDS_BYTES, stream, a); }
#endif
}
```

```cpp
#include <hip/hip_runtime.h>
#include <cstdio>
#include <cstdint>

#ifndef ONE_LAUNCH
#define ONE_LAUNCH 1
#endif

#define GAS __attribute__((address_space(1)))
#define LAS __attribute__((address_space(3)))
typedef _Float16 half_t;
typedef _Float16 h16x8 __attribute__((ext_vector_type(8)));
typedef _Float16 h16x4 __attribute__((ext_vector_type(4)));
typedef _Float16 h16x2 __attribute__((ext_vector_type(2)));
typedef float f32x4 __attribute__((ext_vector_type(4)));
typedef float f32x2 __attribute__((ext_vector_type(2)));
typedef unsigned u32x4 __attribute__((ext_vector_type(4)));
typedef unsigned u32x2 __attribute__((ext_vector_type(2)));

constexpr int D = 2048, BATCH = 8, SEQ = 2048, M = BATCH * SEQ, DEPTH = 4, MEML = 256, HD = 128;
constexpr int A_HEADS = 6, IDX_HEADS = 16, IDX_DIM = 64, TOPK = 256, B_HEADS = 6, QL = 512, KVL = 512, NOPE = 128, ROPE = 64, VD = 128, C_HEADS = 4;
constexpr int DFF = 5632, IN_COLS = 9872, PROJ_LD = 9984;
constexpr int QB_LD = 1280, KVB_LD = 1536, LATN_LD = 1024;
constexpr float LN_EPS = 1e-5f, RMS_EPS = 1e-6f;
constexpr float ALPHA = 1.681792830507429f;
constexpr int PC_AQ = 0, PC_AK = 768, PC_AV = 896, PC_IQ = 1024, PC_IK = 2048, PC_KR = 2112, PC_IW = 2176, PC_CQL = 2304, PC_CKVL = 2816, PC_CQ = 3328, PC_GATES = 3840;
constexpr int NWAVES = 8, NTHREADS = 512;

constexpr size_t al256(size_t x) { return (x + 255) & ~(size_t)255; }
constexpr size_t WS_CTL = 0, CTL_ZERO_BYTES = 1u << 20;
constexpr size_t SZ_WUP = (size_t)2 * DFF * D * 2, SZ_WDN = (size_t)D * DFF * 2, SZ_WIN = (size_t)PROJ_LD * D * 2, SZ_WUQ = (size_t)QB_LD * QL * 2, SZ_WUKV = (size_t)KVB_LD * KVL * 2;
constexpr size_t SZ_WBR = (size_t)D * D * 2, SZ_WOUT = (size_t)D * D * 2;
constexpr size_t LW_UP1 = 0, LW_DN1 = LW_UP1 + SZ_WUP, LW_IN = LW_DN1 + SZ_WDN, LW_UQ = LW_IN + SZ_WIN, LW_UKV = LW_UQ + SZ_WUQ, LW_BR = LW_UKV + SZ_WUKV, LW_OUT = LW_BR + SZ_WBR,
                 LW_UP2 = LW_OUT + SZ_WOUT, LW_DN2 = LW_UP2 + SZ_WUP, LW_END = LW_DN2 + SZ_WDN;
constexpr size_t WS_W = CTL_ZERO_BYTES;
constexpr size_t WS_WMEM = WS_W + (size_t)DEPTH * LW_END;
constexpr size_t WS_X16 = WS_WMEM + (size_t)DEPTH * 1024 * D * 2;
constexpr size_t WS_R1 = WS_X16 + (size_t)M * D * 2;
constexpr size_t R1_PRELN = (size_t)M * DFF * 2;
constexpr size_t WS_OCAT = WS_R1 + (size_t)M * PROJ_LD * 2;
constexpr size_t WS_QB = WS_OCAT + (size_t)M * D * 2;
constexpr size_t WS_KVB = WS_QB + (size_t)M * QB_LD * 2;
constexpr size_t WS_LATN = WS_KVB + (size_t)M * KVB_LD * 2;
constexpr size_t WS_KROPE = WS_LATN + (size_t)M * LATN_LD * 2;
constexpr size_t WS_TMP = WS_KROPE + (size_t)M * ROPE * 2;
constexpr size_t WS_SEL = WS_TMP + (size_t)M * D * 4;
constexpr size_t WS_CS = WS_SEL + (size_t)M * TOPK * 2;
constexpr size_t WS_MEM16 = WS_CS + (size_t)M * 64 * 4;
constexpr size_t WS_MEMKV = WS_MEM16 + (size_t)BATCH * MEML * D * 2;
constexpr size_t WS_LUT = WS_MEMKV + (size_t)BATCH * MEML * 4096 * 2;
constexpr size_t WS_END = WS_LUT + 1024;
static_assert(R1_PRELN + (size_t)M * D * 4 <= (size_t)M * PROJ_LD * 2, "preLN fits behind h16");
static_assert(WS_W % 256 == 0 && LW_END % 256 == 0, "align");

constexpr int CW_BAR = 4096;

constexpr int RING_BYTES = 131072, LDSCTL_OFF = RING_BYTES, LDS_BYTES = 147456;

#define LDS_WAIT() asm volatile("s_waitcnt lgkmcnt(0)" ::: "memory")
#define VM_WAIT() asm volatile("s_waitcnt vmcnt(0)" ::: "memory")
__device__ __forceinline__ unsigned pkh(float lo, float hi) { h16x2 v; v.x = (half_t)lo; v.y = (half_t)hi; return __builtin_bit_cast(unsigned, v); }
__device__ __forceinline__ float wave_sum(float v) {
#pragma unroll
    for (int o = 1; o < 64; o <<= 1) v += __shfl_xor(v, o);
    return v;
}
__device__ __forceinline__ float wave_max(float v) {
#pragma unroll
    for (int o = 1; o < 64; o <<= 1) v = fmaxf(v, __shfl_xor(v, o));
    return v;
}
__device__ __forceinline__ float fast_sigmoid(float x) { return __builtin_amdgcn_rcpf(1.0f + __builtin_amdgcn_exp2f(-1.4426950408889634f * x)); }

#define XB_TMO      128
#define XB_XCNT(j)  (256  + 64 * (j))
#define XB_XSUB(j)  (1280 + 64 * (j))
#define XB_XGEN(j)  (2304 + 64 * (j))
#define XB_TOP      3328
#define XB_TOPGEN   3392
#define XCD_BAR_WORDS 3456
#define XB_SPIN_CAP (1u << 20)
__device__ __forceinline__ unsigned xb_ld(unsigned* p)              { return __hip_atomic_load(p, __ATOMIC_RELAXED, __HIP_MEMORY_SCOPE_AGENT); }
__device__ __forceinline__ unsigned xb_add(unsigned* p, unsigned v) { return __hip_atomic_fetch_add(p, v, __ATOMIC_RELAXED, __HIP_MEMORY_SCOPE_AGENT); }
__device__ __forceinline__ unsigned xb_xcc_id() { return (unsigned)__builtin_amdgcn_s_getreg((3 << 11) | 20) & 0xFu; }
#define XB_SPIN(cond, bar) do { unsigned _sp = 0; while (cond) { __builtin_amdgcn_s_sleep(1); \
    if ((++_sp & 255u) == 0u) { if (xb_ld(&(bar)[XB_TMO])) break; if (_sp > XB_SPIN_CAP) { atomicAdd(&(bar)[XB_TMO], 1u); break; } } } } while (0)
struct XcdBarrier { unsigned* bar; unsigned x; volatile LAS unsigned* st; };
__device__ __forceinline__ XcdBarrier xcd_barrier_post(unsigned* bar, volatile LAS unsigned* st) {
    XcdBarrier b; b.bar = bar; b.x = xb_xcc_id(); b.st = st;
    if (threadIdx.x == 0) (void)xb_add(&bar[XB_XCNT(b.x)], 1u);
    return b;
}
__device__ __forceinline__ void xcd_barrier_complete(unsigned* bar, unsigned x, unsigned& nloc, unsigned& nx) {
    const unsigned G = gridDim.x * gridDim.y * gridDim.z;
    unsigned sum, cnt, mine, sp = 0u;
    for (;;) {
        sum = 0u; cnt = 0u; mine = 0u;
#pragma unroll
        for (unsigned j = 0; j < 16; ++j) { const unsigned c = xb_ld(&bar[XB_XCNT(j)]); sum += c; cnt += (c > 0u) ? 1u : 0u; mine = (j == x) ? c : mine; }
        if (sum == G) break;
        __builtin_amdgcn_s_sleep(1);
        if ((++sp & 255u) == 0u) { if (xb_ld(&bar[XB_TMO])) break; if (sp > XB_SPIN_CAP) { atomicAdd(&bar[XB_TMO], 1u); break; } }
    }
    nloc = mine > 0u ? mine : 1u; nx = cnt > 0u ? cnt : 1u;
}
__device__ __forceinline__ void xcd_barrier(const XcdBarrier& b) {
    asm volatile("s_waitcnt vmcnt(0)" ::: "memory");
    __syncthreads();
    if (threadIdx.x == 0) {
        unsigned* bar = b.bar;
        __builtin_amdgcn_s_waitcnt(0);
        const unsigned nloc = b.st[0], nx = b.st[1];
        const unsigned old = xb_add(&bar[XB_XSUB(b.x)], 1u);
        const unsigned gen = old / nloc;
        if (old + 1u == (gen + 1u) * nloc) {
            __builtin_amdgcn_fence(__ATOMIC_RELEASE, "agent");
            asm volatile("s_waitcnt vmcnt(0)" ::: "memory");
            const unsigned og = xb_add(&bar[XB_TOP], 1u);
            const unsigned tg = og / nx;
            if (og + 1u == (tg + 1u) * nx) xb_add(&bar[XB_TOPGEN], 1u);
            else XB_SPIN(xb_ld(&bar[XB_TOPGEN]) == tg, bar);
            __builtin_amdgcn_fence(__ATOMIC_ACQUIRE, "agent");
            xb_add(&bar[XB_XGEN(b.x)], 1u);
            asm volatile("s_waitcnt vmcnt(0)" ::: "memory");
        } else {
            XB_SPIN(xb_ld(&bar[XB_XGEN(b.x)]) == gen, bar);
            __builtin_amdgcn_fence(__ATOMIC_ACQUIRE, "agent");
            asm volatile("s_waitcnt vmcnt(0)" ::: "memory");
        }
    }
    __syncthreads();
}

namespace pg8 {
constexpr int BM = 256, BK = 64, HALF = 128, HTB = HALF * BK * 2, STAGE_BYTES = 8 * HTB, NXCD = 8, WGM = 8;
__host__ __device__ __forceinline__ int lds_byte(int r, int c) { const int st = (r >> 4) * 2 + (c >> 5), rr = r & 15, cc = c & 31, ob = rr * 64 + cc * 2; return st * 1024 + (ob ^ (((ob >> 9) & 1) << 5)); }
__host__ __device__ __forceinline__ void stage_rc(int b, int& R, int& C) { const int st = b / 1024, sb = b % 1024, swz = sb ^ (((sb >> 9) & 1) << 5); R = (st >> 1) * 16 + swz / 64; C = (st & 1) * 32 + (swz % 64) / 2; }
__host__ __device__ __forceinline__ int perm32(int rho) { const int n = rho >> 4, i = rho & 15; return 8 * (i >> 2) + 4 * n + (i & 3); }
struct Unit { int pm, pn; };
struct Gemm { const half_t* A; const half_t* Bt; int lda, ldb, K; };
struct StaticOrder {
    int nM, nN, nwg, G, c;
    __host__ __device__ void init(int M_, int N_, int G_, int c_) { nM = M_ / BM; nN = N_ / BM; nwg = nM * nN; G = G_; c = c_; }
    __host__ __device__ bool next(int i, Unit& u) const {
        const long L = (long)i * G + c; if (L >= nwg) return false;
        int wgid = (int)L; { const int q = nwg / NXCD, r = nwg % NXCD, xcd = wgid % NXCD, off = wgid / NXCD; wgid = (xcd < r ? xcd * (q + 1) : r * (q + 1) + (xcd - r) * q) + off; }
        const int nig = WGM * nN, gid = wgid / nig, fm = gid * WGM, gsz = (nM - fm) < WGM ? (nM - fm) : WGM;
        u.pm = fm + ((wgid % nig) % gsz); u.pn = (wgid % nig) / gsz; return true;
    }
};
template <class Epi>
__device__ __forceinline__ void gemm_phase(LAS unsigned char* lds, const Gemm g, const StaticOrder& S, const Epi& E) {
    int tid_ = threadIdx.x; asm volatile("" : "+v"(tid_));
    const int tid = tid_, wid = __builtin_amdgcn_readfirstlane(tid >> 6), lane = tid & 63, wr = wid >> 2, wc = wid & 3, fr = lane & 15, fq = lane >> 4;
    const int K = g.K, nt = K / BK;
    unsigned voffA[2], voffB[2];
#pragma unroll
    for (int i = 0; i < 2; ++i) { int R, C; stage_rc(tid * 16 + i * 8192, R, C); const int Rb = Epi::PERM ? ((R & ~31) + perm32(R & 31)) : R;
        voffA[i] = (unsigned)(R * g.lda + C) * 2u; voffB[i] = (unsigned)(Rb * g.ldb + C) * 2u; }
    const size_t kstep = (size_t)(BK * 2);
    const size_t hstepA = (size_t)HALF * g.lda * 2, hstepB = (size_t)HALF * g.ldb * 2;
    const size_t tstepA = 2 * hstepA, tstepB = 2 * hstepB;
    const unsigned ldsw = (unsigned)wid * 1024u;
    const int aoff = lds_byte(wr * 64 + fr, fq * 8), boff = lds_byte(wc * 32 + fr, fq * 8);
#define PG8_SA(b, h) (((b) * 2 + (h)) * HTB)
#define PG8_SB(b, h) ((4 + (b) * 2 + (h)) * HTB)
#define PG8_STAGE(bufoff, gbase, voff) do { _Pragma("unroll") for (int _i = 0; _i < 2; ++_i) \
        __builtin_amdgcn_global_load_lds((const unsigned*)((const char*)(gbase) + (voff)[_i]), (LAS unsigned*)(lds + (bufoff) + ldsw + _i * 8192), 16, 0, 0); } while (0)
#define PG8_LDA(dst, b, h) do { _Pragma("unroll") for (int m = 0; m < 4; ++m) _Pragma("unroll") for (int k = 0; k < 2; ++k) dst[m][k] = *(const LAS h16x8*)(lds + PG8_SA(b, h) + aoff + m * 2048 + k * 1024); } while (0)
#define PG8_LDB(dst, b, h) do { _Pragma("unroll") for (int n = 0; n < 2; ++n) _Pragma("unroll") for (int k = 0; k < 2; ++k) dst[n][k] = *(const LAS h16x8*)(lds + PG8_SB(b, h) + boff + n * 2048 + k * 1024); } while (0)
#define PG8_MMA(ai, bj, At, Bt) do { __builtin_amdgcn_s_setprio(1); _Pragma("unroll") for (int m = 0; m < 4; ++m) _Pragma("unroll") for (int n = 0; n < 2; ++n) _Pragma("unroll") for (int k = 0; k < 2; ++k) \
        acc[ai][bj][m][n] = __builtin_amdgcn_mfma_f32_16x16x32_f16(Bt[n][k], At[m][k], acc[ai][bj][m][n], 0, 0, 0); __builtin_amdgcn_s_setprio(0); } while (0)
#define PG8_WAIT_V(n) asm volatile("s_waitcnt vmcnt(" #n ")" ::: "memory")
#define PG8_WAIT_L(n) asm volatile("s_waitcnt lgkmcnt(" #n ")" ::: "memory")
#define PG8_BAR __builtin_amdgcn_s_barrier()
#define PG8_SCHED __builtin_amdgcn_sched_barrier(0)
    Unit cur, nxt; int ui = 0;
    if (!S.next(0, cur)) return;
    f32x4 acc[2][2][4][2];
#pragma unroll
    for (int a = 0; a < 2; ++a)
#pragma unroll
        for (int b = 0; b < 2; ++b)
#pragma unroll
            for (int m = 0; m < 4; ++m)
#pragma unroll
                for (int n = 0; n < 2; ++n) acc[a][b][m][n] = (f32x4){0.f, 0.f, 0.f, 0.f};
    h16x8 At[4][2], B0[2][2], B1[2][2];
    const char* cA = (const char*)g.A + (size_t)cur.pm * tstepA; const char* cB = (const char*)g.Bt + (size_t)cur.pn * tstepB;
    PG8_STAGE(PG8_SB(0, 0), cB, voffB); PG8_STAGE(PG8_SB(0, 1), cB + hstepB, voffB); PG8_STAGE(PG8_SA(0, 0), cA, voffA); PG8_STAGE(PG8_SA(0, 1), cA + hstepA, voffA);
    if (wr == 1) PG8_BAR;
    PG8_WAIT_V(2); PG8_BAR;
    PG8_STAGE(PG8_SB(1, 0), cB + kstep, voffB); PG8_STAGE(PG8_SA(1, 0), cA + kstep, voffA); PG8_STAGE(PG8_SB(1, 1), cB + hstepB + kstep, voffB);
    PG8_WAIT_V(6); PG8_BAR;
    for (;;) {
        const bool has_next = S.next(ui + 1, nxt);
        const char* nA = has_next ? (const char*)g.A + (size_t)nxt.pm * tstepA : cA; const char* nB = has_next ? (const char*)g.Bt + (size_t)nxt.pn * tstepB : cB;
        for (int t = 0; t < nt; t += 2) {
            const bool last = (t == nt - 2);
            const char* a1 = cA + (size_t)(t + 1) * kstep;
            const char* a2 = last ? nA : cA + (size_t)(t + 2) * kstep; const char* b2 = last ? nB : cB + (size_t)(t + 2) * kstep;
            const char* a3 = a2 + kstep; const char* b3 = b2 + kstep;
            E.mid(acc, cur, t, wr, wc, fr, fq);
            PG8_LDB(B0, 0, 0); PG8_LDB(B1, 0, 1); PG8_SCHED; PG8_LDA(At, 0, 0); PG8_STAGE(PG8_SA(1, 1), a1 + hstepA, voffA);
            PG8_WAIT_V(8); PG8_WAIT_L(0); PG8_BAR; PG8_MMA(0, 0, At, B0); PG8_MMA(0, 1, At, B1); PG8_BAR; PG8_SCHED;
            PG8_LDA(At, 0, 1); PG8_STAGE(PG8_SB(0, 0), b2, voffB); PG8_STAGE(PG8_SB(0, 1), b2 + hstepB, voffB); PG8_STAGE(PG8_SA(0, 0), a2, voffA);
            PG8_WAIT_V(8); PG8_WAIT_L(0); PG8_BAR; PG8_MMA(1, 0, At, B0); PG8_MMA(1, 1, At, B1); PG8_BAR; PG8_SCHED;
            PG8_LDB(B0, 1, 0); PG8_LDB(B1, 1, 1); PG8_SCHED; PG8_LDA(At, 1, 0); PG8_STAGE(PG8_SA(0, 1), a2 + hstepA, voffA);
            PG8_WAIT_V(8); PG8_WAIT_L(0); PG8_BAR; PG8_MMA(0, 0, At, B0); PG8_MMA(0, 1, At, B1); PG8_BAR; PG8_SCHED;
            PG8_LDA(At, 1, 1); PG8_STAGE(PG8_SB(1, 0), b3, voffB); PG8_STAGE(PG8_SB(1, 1), b3 + hstepB, voffB); PG8_STAGE(PG8_SA(1, 0), a3, voffA);
            PG8_WAIT_V(8); PG8_WAIT_L(0); PG8_BAR; PG8_MMA(1, 0, At, B0); PG8_MMA(1, 1, At, B1); PG8_BAR; PG8_SCHED;
        }
        if (wr == 0) PG8_BAR;
        E(acc, cur, wr, wc, fr, fq);
        if (!has_next) break;
#pragma unroll
        for (int a = 0; a < 2; ++a)
#pragma unroll
            for (int b = 0; b < 2; ++b)
#pragma unroll
                for (int m = 0; m < 4; ++m)
#pragma unroll
                    for (int n = 0; n < 2; ++n) acc[a][b][m][n] = (f32x4){0.f, 0.f, 0.f, 0.f};
        cur = nxt; cA = nA; cB = nB; ++ui;
        if (wr == 1) PG8_BAR;
    }
    PG8_WAIT_V(0);
    PG8_BAR;
#undef PG8_SA
#undef PG8_SB
#undef PG8_STAGE
#undef PG8_LDA
#undef PG8_LDB
#undef PG8_MMA
#undef PG8_WAIT_V
#undef PG8_WAIT_L
#undef PG8_BAR
#undef PG8_SCHED
}

typedef f32x4 Acc[2][2][4][2];
struct EpiBase { __device__ __forceinline__ void mid(Acc&, const Unit&, int, int, int, int, int) const {} };
struct EpiSwiglu : EpiBase {
    static constexpr bool PERM = true;
    half_t* H; int ldh;
    __device__ __forceinline__ void operator()(const Acc& acc, const Unit& u, int wr, int wc, int fr, int fq) const {
        const int row0 = u.pm * BM + wr * 64 + fr, col0 = u.pn * 128 + wc * 32 + 8 * fq;
#pragma unroll
        for (int ai = 0; ai < 2; ++ai)
#pragma unroll
            for (int m = 0; m < 4; ++m) {
                half_t* rowp = H + (size_t)(row0 + ai * HALF + m * 16) * ldh + col0;
                float o[8];
#pragma unroll
                for (int n = 0; n < 2; ++n)
#pragma unroll
                    for (int j = 0; j < 4; ++j) { const float gt = acc[ai][0][m][n][j], up = acc[ai][1][m][n][j]; o[n * 4 + j] = gt * fast_sigmoid(gt) * up; }
                u32x4 w; w.x = pkh(o[0], o[1]); w.y = pkh(o[2], o[3]); w.z = pkh(o[4], o[5]); w.w = pkh(o[6], o[7]);
                *(u32x4*)rowp = w;
            }
    }
};
struct EpiResid : EpiBase {
    static constexpr bool PERM = false;
    const float* X; float* O; float alpha, coef;
    __device__ __forceinline__ void operator()(const Acc& acc, const Unit& u, int wr, int wc, int fr, int fq) const {
        const int row0 = u.pm * BM + wr * 64 + fr, col0 = u.pn * BM + wc * 32 + 4 * fq;
#pragma unroll
        for (int ai = 0; ai < 2; ++ai)
#pragma unroll
            for (int m = 0; m < 4; ++m) { const size_t off = (size_t)(row0 + ai * HALF + m * 16) * D + col0;
#pragma unroll
                for (int bj = 0; bj < 2; ++bj)
#pragma unroll
                    for (int n = 0; n < 2; ++n) { const f32x4 xv = *(const f32x4*)(X + off + bj * HALF + n * 16);
                        *(f32x4*)(O + off + bj * HALF + n * 16) = xv * alpha + acc[ai][bj][m][n] * coef; }
                asm volatile("" ::: "memory"); }
    }
};
struct EpiH16 : EpiBase {
    static constexpr bool PERM = true;
    half_t* O; int ldc; int sig_from;
    __device__ __forceinline__ void operator()(const Acc& acc, const Unit& u, int wr, int wc, int fr, int fq) const {
        const int row0 = u.pm * BM + wr * 64 + fr, col0 = u.pn * BM + wc * 32 + 8 * fq;
        const bool sg = u.pn >= sig_from;
#pragma unroll
        for (int ai = 0; ai < 2; ++ai)
#pragma unroll
            for (int m = 0; m < 4; ++m) { half_t* rowp = O + (size_t)(row0 + ai * HALF + m * 16) * ldc + col0;
#pragma unroll
                for (int bj = 0; bj < 2; ++bj) { f32x4 v0 = acc[ai][bj][m][0], v1 = acc[ai][bj][m][1];
                    if (sg) {
#pragma unroll
                        for (int j = 0; j < 4; ++j) { v0[j] = fast_sigmoid(v0[j]); v1[j] = fast_sigmoid(v1[j]); } }
                    u32x4 w; w.x = pkh(v0[0], v0[1]); w.y = pkh(v0[2], v0[3]); w.z = pkh(v1[0], v1[1]); w.w = pkh(v1[2], v1[3]);
                    *(u32x4*)(rowp + bj * HALF) = w; } }
    }
};
template <int MODE> struct EpiBranch : EpiBase {
    static constexpr bool PERM = false;
    const half_t* G; int ldg; float* T; half_t* O;
    __device__ __forceinline__ void operator()(const Acc& acc, const Unit& u, int wr, int wc, int fr, int fq) const {
        const int row0 = u.pm * BM + wr * 64 + fr, col0 = u.pn * BM + wc * 32 + 4 * fq;
#pragma unroll
        for (int ai = 0; ai < 2; ++ai)
#pragma unroll
            for (int m = 0; m < 4; ++m) { const int row = row0 + ai * HALF + m * 16; const size_t off = (size_t)row * D + col0;
#pragma unroll
                for (int bj = 0; bj < 2; ++bj)
#pragma unroll
                    for (int n = 0; n < 2; ++n) { const int co = bj * HALF + n * 16;
                        const h16x4 gv = *(const h16x4*)(G + (size_t)row * ldg + col0 + co);
                        f32x4 v = acc[ai][bj][m][n]; v[0] *= (float)gv[0]; v[1] *= (float)gv[1]; v[2] *= (float)gv[2]; v[3] *= (float)gv[3];
                        if (MODE >= 1) v += *(const f32x4*)(T + off + co);
                        if (MODE <= 1) *(f32x4*)(T + off + co) = v;
                        else { u32x2 w; w.x = pkh(v[0], v[1]); w.y = pkh(v[2], v[3]); *(u32x2*)(O + off + co) = w; } }
                asm volatile("" ::: "memory"); }
    }
};
}

struct Args { const void* in[18]; float* out; unsigned char* ws; int ph_lo, ph_hi; };
struct Frame {
    LAS unsigned char* lds;
    int tid, lane, wave, G, gw, NGW;
    unsigned char* ws;
};

__device__ __forceinline__ int map_col(int kind, int n, float& scale) {
    scale = 1.f;
    if (kind == 0) return n;
    if (kind == 1) { if (n < DFF) return 256 * (n >> 7) + (n & 127); const int q = n - DFF; return 256 * (q >> 7) + 128 + (q & 127); }
    if (n < 2112) return n;
    if (n < 2128) { scale = 1.0f / 32.0f; return n + 64; }
    if (n < 3152) return n + 176;
    if (n < 3216) return n - 1040;
    return n + 112;
}
__device__ __forceinline__ void transpose_item(const float* W, int K, int N, half_t* WT, int kind, LAS float* scr, int item, int lane) {
    const int nblk = (N + 31) / 32, kb = item / nblk, nb = item % nblk, k0 = 64 * kb, n0 = 32 * nb;
    const int nl = (n0 + (lane & 31) < N) ? n0 + (lane & 31) : N - 1;
#pragma unroll 8
    for (int i = 0; i < 32; ++i) { const int kk = 2 * i + (lane >> 5); scr[kk * 33 + (lane & 31)] = W[(size_t)(k0 + kk) * N + nl]; }
    LDS_WAIT(); asm volatile("" ::: "memory");
    const int c = lane & 7;
#pragma unroll
    for (int j = 0; j < 4; ++j) { const int nn = (lane >> 3) + 8 * j; const int n = n0 + nn;
        if (n < N) { float sc; const int dr = map_col(kind, n, sc); const LAS float* s = scr + (8 * c) * 33 + nn;
            u32x4 o; o.x = pkh(s[0 * 33] * sc, s[1 * 33] * sc); o.y = pkh(s[2 * 33] * sc, s[3 * 33] * sc); o.z = pkh(s[4 * 33] * sc, s[5 * 33] * sc); o.w = pkh(s[6 * 33] * sc, s[7 * 33] * sc);
            *(u32x4*)(WT + (size_t)dr * K + k0 + 8 * c) = o; } }
    LDS_WAIT(); asm volatile("" ::: "memory");
}
__device__ __forceinline__ void cvt_f32_to_h16(const float* src, half_t* dst, size_t n8, size_t i0, size_t stride) {
    for (size_t i = i0; i < n8; i += stride) { const f32x4 a = *(const f32x4*)(src + i * 8), b = *(const f32x4*)(src + i * 8 + 4);
        u32x4 o; o.x = pkh(a[0], a[1]); o.y = pkh(a[2], a[3]); o.z = pkh(b[0], b[1]); o.w = pkh(b[2], b[3]); *(u32x4*)(dst + i * 8) = o; }
}

__device__ __forceinline__ void sincos_f32arg(float ang, float& c, float& s) {
    const double x = (double)ang; const double k = __builtin_rint(x * 0.15915494309189535); const double r = x - k * 6.283185307179586; const double r2 = r * r;
    double ts = r, sn = r, tc = 1.0, cn = 1.0;
#pragma unroll 1
    for (int i = 1; i <= 14; ++i) { ts *= -r2 / (double)((2 * i) * (2 * i + 1)); sn += ts; tc *= -r2 / (double)((2 * i - 1) * (2 * i)); cn += tc; }
    c = (float)cn; s = (float)sn;
}
#define PRO_JOB(Wp, Kv, Nv, WTp, kindv) do { const float* _W = (Wp); half_t* _WT = (WTp); const int _nitems = ((Kv) / 64) * (((Nv) + 31) / 32); \
    for (int it = F.gw; it < _nitems; it += F.NGW) transpose_item(_W, (Kv), (Nv), _WT, (kindv), scr, it, F.lane); } while (0)
__device__ __forceinline__ void phase_prologue(const Frame& F0, const Args __attribute__((address_space(4)))* argsp) {
    Frame F = F0; asm volatile("" : "+v"(F.lane)); asm volatile("" : "+s"(F.gw));
#define args (*argsp)
    LAS float* scr = (LAS float*)(F.lds + F.wave * 16384);
    unsigned char* ws = F.ws;
#pragma unroll 1
    for (int l = 0; l < DEPTH; ++l) {
        unsigned char* lw = ws + WS_W + (size_t)l * LW_END;
        PRO_JOB((const float*)args.in[6] + (size_t)l * D * 2 * DFF, D, 2 * DFF, (half_t*)(lw + LW_UP1), 1);
        PRO_JOB((const float*)args.in[7] + (size_t)l * DFF * D, DFF, D, (half_t*)(lw + LW_DN1), 0);
        PRO_JOB((const float*)args.in[8] + (size_t)l * D * IN_COLS, D, IN_COLS, (half_t*)(lw + LW_IN), 2);
        PRO_JOB((const float*)args.in[11] + (size_t)l * QL * 1152, QL, 1152, (half_t*)(lw + LW_UQ), 0);
        PRO_JOB((const float*)args.in[12] + (size_t)l * KVL * 1536, KVL, 1536, (half_t*)(lw + LW_UKV), 0);
        PRO_JOB((const float*)args.in[14] + (size_t)l * D * D, D, D, (half_t*)(lw + LW_BR), 0);
        PRO_JOB((const float*)args.in[15] + (size_t)l * D * D, D, D, (half_t*)(lw + LW_OUT), 0);
        PRO_JOB((const float*)args.in[16] + (size_t)l * D * 2 * DFF, D, 2 * DFF, (half_t*)(lw + LW_UP2), 1);
        PRO_JOB((const float*)args.in[17] + (size_t)l * DFF * D, DFF, D, (half_t*)(lw + LW_DN2), 0);
        PRO_JOB((const float*)args.in[13] + (size_t)l * D * 1024, D, 1024, (half_t*)(ws + WS_WMEM) + (size_t)l * 1024 * D, 0);
        { u32x4 z = {0u, 0u, 0u, 0u}; const size_t gt = (size_t)F.gw * 64 + F.lane, gs = (size_t)F.NGW * 64;
          u32x4* p1 = (u32x4*)((half_t*)(lw + LW_IN) + (size_t)2192 * D); for (size_t i = gt; i < (size_t)112 * D / 8; i += gs) p1[i] = z;
          u32x4* p2 = (u32x4*)((half_t*)(lw + LW_UQ) + (size_t)1152 * QL); for (size_t i = gt; i < (size_t)128 * QL / 8; i += gs) p2[i] = z; }
    }
    const size_t gt = (size_t)F.gw * 64 + F.lane, gs = (size_t)F.NGW * 64;
    cvt_f32_to_h16((const float*)args.in[0], (half_t*)(ws + WS_X16), (size_t)M * D / 8, gt, gs);
    cvt_f32_to_h16((const float*)args.in[1], (half_t*)(ws + WS_MEM16), (size_t)BATCH * MEML * D / 8, gt, gs);
    { const int* pos = (const int*)args.in[2]; float* cs = (float*)(ws + WS_CS);
      for (size_t i = gt; i < (size_t)M * 32; i += gs) { const int m = (int)(i >> 5), f = (int)(i & 31);
          double v = 1.0; for (int q = 0; q < f; ++q) v *= 0.7498942093324559;
          const float inv_freq = (float)v; const float ang = (float)pos[m] * inv_freq; float c, s; sincos_f32arg(ang, c, s);
          cs[(size_t)m * 64 + f] = c; cs[(size_t)m * 64 + 32 + f] = s; } }
    if (F.gw == 0) { int* lut = (int*)(ws + WS_LUT);
#undef args
        for (int n = F.lane; n <= 128; n += 64) { int bkt; if (n < 16) bkt = n; else { const float lg2 = __builtin_amdgcn_logf((float)n * (1.0f / 16.0f)); int lg = 16 + (int)(lg2 * (16.0f / 3.0f)); bkt = lg < 31 ? lg : 31; } lut[n] = bkt; } }
}

__device__ __forceinline__ void phase_ln(const Frame& F0, const float* pre, const float* g, const float* b, float* xout, half_t* x16) {
    Frame F = F0; asm volatile("" : "+v"(F.lane)); asm volatile("" : "+s"(F.gw));
    for (int m = F.gw; m < M; m += F.NGW) {
        const f32x4* xr = (const f32x4*)(pre + (size_t)m * D) + F.lane;
        f32x4 v[8]; float s = 0.f;
#pragma unroll
        for (int j = 0; j < 8; ++j) { v[j] = xr[64 * j]; s += (v[j][0] + v[j][1]) + (v[j][2] + v[j][3]); }
        const float mean = wave_sum(s) * (1.f / D); float s2 = 0.f;
#pragma unroll
        for (int j = 0; j < 8; ++j) { v[j] = v[j] - mean; s2 += (v[j][0] * v[j][0] + v[j][1] * v[j][1]) + (v[j][2] * v[j][2] + v[j][3] * v[j][3]); }
        const float rstd = 1.0f / sqrtf(wave_sum(s2) * (1.f / D) + LN_EPS);
#pragma unroll
        for (int j = 0; j < 8; ++j) { const int c = 4 * (F.lane + 64 * j); const f32x4 gg = *(const f32x4*)(g + c), bb = *(const f32x4*)(b + c);
            const f32x4 o = v[j] * rstd * gg + bb;
            *(f32x4*)(xout + (size_t)m * D + c) = o;
            u32x2 w; w.x = pkh(o[0], o[1]); w.y = pkh(o[2], o[3]); *(u32x2*)(x16 + (size_t)m * D + c) = w; }
    }
}

__device__ __forceinline__ unsigned sortable(float f) { f = f + 0.0f; unsigned u = __builtin_bit_cast(unsigned, f); return (u & 0x80000000u) ? ~u : (u | 0x80000000u); }
__device__ __forceinline__ void phase_p5(const Frame& F0, const half_t* proj, const float* qn, const float* kvn, half_t* latn, half_t* krope, const float* cs, unsigned short* sel) {
    Frame F = F0; asm volatile("" : "+v"(F.lane)); asm volatile("" : "+s"(F.gw));
    for (int m = F.gw; m < M; m += F.NGW) {
        const half_t* pr = proj + (size_t)m * PROJ_LD;
#pragma unroll
        for (int w = 0; w < 2; ++w) {
            const h16x8 v = *(const h16x8*)(pr + (w ? PC_CKVL : PC_CQL) + 8 * F.lane);
            float f[8], s = 0.f;
#pragma unroll
            for (int j = 0; j < 8; ++j) { f[j] = (float)v[j]; s += f[j] * f[j]; }
            const float r = 1.0f / sqrtf(wave_sum(s) * (1.f / 512.f) + RMS_EPS);
            const float* gp = (w ? kvn : qn) + 8 * F.lane;
            u32x4 o; o.x = pkh(f[0] * r * gp[0], f[1] * r * gp[1]); o.y = pkh(f[2] * r * gp[2], f[3] * r * gp[3]); o.z = pkh(f[4] * r * gp[4], f[5] * r * gp[5]); o.w = pkh(f[6] * r * gp[6], f[7] * r * gp[7]);
            *(u32x4*)(latn + (size_t)m * LATN_LD + w * 512 + 8 * F.lane) = o;
        }
        if (F.lane < 32) { const float x1 = (float)pr[PC_KR + F.lane], x2 = (float)pr[PC_KR + 32 + F.lane]; const float c = cs[(size_t)m * 64 + F.lane], s = cs[(size_t)m * 64 + 32 + F.lane];
            krope[(size_t)m * ROPE + F.lane] = (half_t)(x1 * c - x2 * s); krope[(size_t)m * ROPE + 32 + F.lane] = (half_t)(x1 * s + x2 * c); }
    }
}
__device__ __forceinline__ void phase_indexer(const Frame& F0, const half_t* proj, unsigned short* sel) {
    Frame F = F0; asm volatile("" : "+v"(F.lane)); asm volatile("" : "+v"(F.tid)); asm volatile("" : "+s"(F.wave));
    const int lane = F.lane, tid = F.tid, wave = F.wave, g4 = lane >> 4, l15 = lane & 15, hi = lane >> 5, mid = (lane >> 4) & 1;
    LAS unsigned char* lds = F.lds;
    constexpr int CHB = 256 * 128;
    const int srow = tid >> 1, spc = (tid & 1) * 4;
#pragma unroll 1
    for (int gi = blockIdx.x; gi < BATCH * 256; gi += F.G) {
        const int b = gi >> 8, rr = gi & 255, tg = (b & 1) ? 255 - rr : rr;
        const int t0 = 8 * tg, t = t0 + wave, m = b * SEQ + t, nk = t + 1;
        unsigned short* so = sel + (size_t)m * TOPK;
        if (t0 < TOPK) {
            for (int j = lane; j < TOPK; j += 64) so[j] = (unsigned short)(j < nk ? j : 0);
            continue;
        }
        const half_t* pr = proj + (size_t)m * PROJ_LD;
        h16x8 af[2]; float w4[4];
#pragma unroll
        for (int ks = 0; ks < 2; ++ks) af[ks] = *(const h16x8*)(pr + PC_IQ + l15 * 64 + 32 * ks + 8 * g4);
#pragma unroll
        for (int r = 0; r < 4; ++r) w4[r] = (float)pr[PC_IW + 4 * g4 + r];
        float sc[32];
#pragma unroll
        for (int j = 0; j < 32; ++j) sc[j] = 0.f;
        const int nch = (t0 + 7) / 256 + 1;
        u32x4 kreg[4];
        const half_t* kbase = proj + (size_t)(b * SEQ + srow) * PROJ_LD + PC_IK + 8 * spc;
#define IDX_ISSUE(ch) do { const half_t* kp = kbase + (size_t)(ch) * 256 * PROJ_LD; _Pragma("unroll") for (int k = 0; k < 4; ++k) kreg[k] = *(const u32x4*)(kp + 8 * k); } while (0)
#define IDX_WRITE(buf) do { _Pragma("unroll") for (int k = 0; k < 4; ++k) *(LAS u32x4*)(lds + (buf) * CHB + srow * 128 + (((spc + k) ^ ((srow >> 1) & 7)) << 4)) = kreg[k]; } while (0)
        __syncthreads();
        IDX_ISSUE(0); IDX_WRITE(0);
        __syncthreads();
#pragma unroll
        for (int g = 0; g < 8; ++g) {
            if (g < nch) {
                if (g + 1 < nch) IDX_ISSUE(g + 1);
                LAS unsigned char* cb = lds + (g & 1) * CHB;
#pragma unroll
                for (int q = 0; q < 4; ++q) {
                    float p[4];
#pragma unroll
                    for (int k4 = 0; k4 < 4; ++k4) {
                        const int row = 16 * (4 * q + k4) + l15; const int sw = (row >> 1) & 7;
                        const h16x8 b0 = *(const LAS h16x8*)(cb + row * 128 + ((g4 ^ sw) << 4)), b1 = *(const LAS h16x8*)(cb + row * 128 + (((g4 + 4) ^ sw) << 4));
                        f32x4 d = {0.f, 0.f, 0.f, 0.f};
                        d = __builtin_amdgcn_mfma_f32_16x16x32_f16(af[0], b0, d, 0, 0, 0);
                        d = __builtin_amdgcn_mfma_f32_16x16x32_f16(af[1], b1, d, 0, 0, 0);
                        p[k4] = (w4[0] * fmaxf(d[0], 0.f) + w4[1] * fmaxf(d[1], 0.f)) + (w4[2] * fmaxf(d[2], 0.f) + w4[3] * fmaxf(d[3], 0.f));
                    }
                    const float sendA = hi ? p[0] : p[2], sendB = hi ? p[1] : p[3];
                    const float keepA = (hi ? p[2] : p[0]) + __shfl_xor(sendA, 32), keepB = (hi ? p[3] : p[1]) + __shfl_xor(sendB, 32);
                    const float send = mid ? keepA : keepB;
                    sc[4 * g + q] = (mid ? keepB : keepA) + __shfl_xor(send, 16);
                }
                if (g + 1 < nch) IDX_WRITE((g + 1) & 1);
                __syncthreads();
            }
        }
#undef IDX_ISSUE
#undef IDX_WRITE
        unsigned u[32];
#pragma unroll
        for (int j = 0; j < 32; ++j) { const int s = 64 * j + lane; u[j] = (s < nk) ? sortable(sc[j]) : 0u; }
        unsigned prefix = 0u;
        for (int bit = 31; bit >= 0; --bit) { const unsigned cand = prefix | (1u << bit); int cnt = 0;
#pragma unroll
            for (int j = 0; j < 32; ++j) cnt += __popcll(__ballot(u[j] >= cand));
            if (cnt >= TOPK) prefix = cand; }
        int cgt = 0;
#pragma unroll
        for (int j = 0; j < 32; ++j) cgt += __popcll(__ballot(u[j] > prefix));
        int need = TOPK - cgt;
        int pos = 0;
        const unsigned long long lt_mask = (1ull << lane) - 1ull;
#pragma unroll
        for (int j = 0; j < 32; ++j) {
            const unsigned long long beq = __ballot(u[j] == prefix);
            const int rank_eq = __popcll(beq & lt_mask);
            const bool pick = (u[j] > prefix) || (u[j] == prefix && rank_eq < need);
            const unsigned long long bp = __ballot(pick);
            if (pick) so[pos + __popcll(bp & lt_mask)] = (unsigned short)(64 * j + lane);
            pos += __popcll(bp);
            const int neq = __popcll(beq); need = need > neq ? need - neq : 0;
        }
        asm volatile("" ::: "memory");
    }
    __syncthreads();
}

template <int NH, bool IS_A>
__device__ __forceinline__ void phase_gattn(const Frame& F0, const half_t* proj, const half_t* memkv, const unsigned short* sel, const int* pos, const float* relb, const int* lut, half_t* ocat) {
    Frame F = F0; asm volatile("" : "+v"(F.lane)); asm volatile("" : "+s"(F.gw));
    LAS unsigned char* wl = F.lds + F.wave * 16384;
    LAS half_t* q_l = (LAS half_t*)wl;
    LAS float* p_l = (LAS float*)(wl + 2048);
    LAS unsigned* idx_l = (LAS unsigned*)(wl + 2048 + 8192);
    LAS float* rb_l = (LAS float*)(wl + 2048 + 8192 + 1024);
    const float scale = 0.08838834764831845f;
    if (IS_A) { for (int i = F.lane; i < 32 * 8; i += 64) rb_l[i] = ((i & 7) < A_HEADS) ? relb[(i >> 3) * A_HEADS + (i & 7)] : 0.f; }
    for (int m = F.gw; m < M; m += F.NGW) {
        const int b = m / SEQ, t = m % SEQ;
        const int nk = IS_A ? (t + 1 < TOPK ? t + 1 : TOPK) : MEML;
        const half_t* qp = proj + (size_t)m * PROJ_LD + (IS_A ? PC_AQ : PC_CQ);
        for (int i = F.lane; i < NH * 16; i += 64) *(LAS u32x4*)(q_l + 8 * i) = *(const u32x4*)(qp + 8 * i);
        for (int j = F.lane; j < 256; j += 64) idx_l[j] = IS_A ? (unsigned)(b * SEQ + sel[(size_t)m * TOPK + j]) : (unsigned)(b * MEML + j);
        LDS_WAIT(); asm volatile("" ::: "memory");
        const int pq = IS_A ? pos[m] : 0;
        float lg[4][NH];
#pragma unroll
        for (int i = 0; i < 4; ++i) {
            const int j = i * 64 + F.lane; const bool valid = j < nk; const unsigned row = idx_l[valid ? j : 0];
            float bias[NH];
#pragma unroll
            for (int h = 0; h < NH; ++h) bias[h] = 0.f;
            if (IS_A) { int dist = pq - pos[row]; dist = dist < 0 ? 0 : (dist > 128 ? 128 : dist); const int bk = lut[dist];
#pragma unroll
                for (int h = 0; h < NH; ++h) bias[h] = rb_l[bk * 8 + h]; }
            if (IS_A) {
                const half_t* kp = proj + (size_t)row * PROJ_LD + PC_AK;
                float d[NH];
#pragma unroll
                for (int h = 0; h < NH; ++h) d[h] = 0.f;
#pragma unroll 4
                for (int c = 0; c < 16; ++c) { const h16x8 kv = *(const h16x8*)(kp + 8 * c);
#pragma unroll
                    for (int h = 0; h < NH; ++h) { const h16x8 qv = *(const LAS h16x8*)(q_l + h * 128 + 8 * c);
#pragma unroll
                        for (int e = 0; e < 4; ++e) { h16x2 qa, ka; qa.x = qv[2 * e]; qa.y = qv[2 * e + 1]; ka.x = kv[2 * e]; ka.y = kv[2 * e + 1]; d[h] = __builtin_amdgcn_fdot2(qa, ka, d[h], false); } } }
#pragma unroll
                for (int h = 0; h < NH; ++h) lg[i][h] = valid ? d[h] * scale + bias[h] : -INFINITY;
            } else {
#pragma unroll
                for (int h = 0; h < NH; ++h) { const half_t* kp = memkv + (size_t)row * 4096 + h * 128; float d = 0.f;
#pragma unroll 4
                    for (int c = 0; c < 16; ++c) { const h16x8 kv = *(const h16x8*)(kp + 8 * c); const h16x8 qv = *(const LAS h16x8*)(q_l + h * 128 + 8 * c);
#pragma unroll
                        for (int e = 0; e < 4; ++e) { h16x2 qa, ka; qa.x = qv[2 * e]; qa.y = qv[2 * e + 1]; ka.x = kv[2 * e]; ka.y = kv[2 * e + 1]; d = __builtin_amdgcn_fdot2(qa, ka, d, false); } }
                    lg[i][h] = valid ? d * scale : -INFINITY; }
            }
        }
#pragma unroll
        for (int h = 0; h < NH; ++h) {
            float mx = fmaxf(fmaxf(lg[0][h], lg[1][h]), fmaxf(lg[2][h], lg[3][h])); mx = wave_max(mx);
            float e[4], s = 0.f;
#pragma unroll
            for (int i = 0; i < 4; ++i) { e[i] = __expf(lg[i][h] - mx); s += e[i]; }
            s = wave_sum(s); const float inv = 1.0f / s;
#pragma unroll
            for (int i = 0; i < 4; ++i) p_l[(i * 64 + F.lane) * 8 + h] = e[i] * inv;
        }
        LDS_WAIT(); asm volatile("" ::: "memory");
        float o[NH][2];
#pragma unroll
        for (int h = 0; h < NH; ++h) { o[h][0] = 0.f; o[h][1] = 0.f; }
#pragma unroll 4
        for (int j = 0; j < nk; ++j) {
            const unsigned row = __builtin_amdgcn_readfirstlane(idx_l[j]);
            const f32x4 p0 = *(const LAS f32x4*)(p_l + j * 8), p1 = *(const LAS f32x4*)(p_l + j * 8 + 4);
            const float pp[8] = {p0[0], p0[1], p0[2], p0[3], p1[0], p1[1], p1[2], p1[3]};
            if (IS_A) { const h16x2 v = *(const h16x2*)(proj + (size_t)row * PROJ_LD + PC_AV + 2 * F.lane); const float v0 = (float)v.x, v1 = (float)v.y;
#pragma unroll
                for (int h = 0; h < NH; ++h) { o[h][0] += pp[h] * v0; o[h][1] += pp[h] * v1; } }
            else {
#pragma unroll
                for (int h = 0; h < NH; ++h) { const h16x2 v = *(const h16x2*)(memkv + (size_t)row * 4096 + 512 + h * 128 + 2 * F.lane); o[h][0] += pp[h] * (float)v.x; o[h][1] += pp[h] * (float)v.y; } }
        }
        half_t* op = ocat + (size_t)m * D + (IS_A ? 0 : 1536);
#pragma unroll
        for (int h = 0; h < NH; ++h) *(unsigned*)(op + h * 128 + 2 * F.lane) = pkh(o[h][0], o[h][1]);
        asm volatile("" ::: "memory");
    }
}

__device__ __forceinline__ void phase_battn(const Frame& F0, const half_t* qb, const half_t* kvb, const half_t* krope, const float* cs, half_t* ocat) {
    Frame F = F0; asm volatile("" : "+v"(F.lane)); asm volatile("" : "+v"(F.tid)); asm volatile("" : "+s"(F.wave));
    constexpr int KROW = 200;
    LAS half_t* k_l = (LAS half_t*)F.lds;
    LAS half_t* v_l = (LAS half_t*)(F.lds + 25600);
    LAS half_t* q_l = (LAS half_t*)(F.lds + 25600 + 16384) + F.wave * 192;
    const float scale = 0.07216878364870322f;
    const int ntask = BATCH * B_HEADS * (SEQ / 8);
    for (int task = blockIdx.x; task < ntask; task += F.G) {
        const int tt = (SEQ / 8 - 1) - task / (BATCH * B_HEADS); const int bh = task % (BATCH * B_HEADS); const int b = bh / B_HEADS, h = bh % B_HEADS;
        const int t = tt * 8 + F.wave, m = b * SEQ + t;
        { const half_t* qp = qb + (size_t)m * QB_LD + h * 192;
          for (int i = F.lane; i < 128; i += 64) q_l[i] = qp[i];
          if (F.lane < 32) { const float x1 = (float)qp[128 + F.lane], x2 = (float)qp[160 + F.lane]; const float c = cs[(size_t)m * 64 + F.lane], s = cs[(size_t)m * 64 + 32 + F.lane];
              q_l[128 + F.lane] = (half_t)(x1 * c - x2 * s); q_l[160 + F.lane] = (half_t)(x1 * s + x2 * c); } }
        float mx = -INFINITY, l = 0.f, o0 = 0.f, o1 = 0.f;
        const int nchunk = (tt * 8 + 8 + 63) / 64;
        for (int c = 0; c < nchunk; ++c) {
            __syncthreads();
            for (int i = F.tid; i < 64 * 24; i += NTHREADS) { const int r = i / 24, pc = i % 24; const int row = b * SEQ + c * 64 + r;
                const u32x4 v = (pc < 16) ? *(const u32x4*)(kvb + (size_t)row * KVB_LD + h * 256 + 8 * pc) : *(const u32x4*)(krope + (size_t)row * ROPE + 8 * (pc - 16));
                *(LAS u32x4*)(k_l + r * KROW + 8 * pc) = v; }
            for (int i = F.tid; i < 64 * 16; i += NTHREADS) { const int r = i / 16, pc = i % 16; const int row = b * SEQ + c * 64 + r;
                *(LAS u32x4*)(v_l + r * 128 + 8 * pc) = *(const u32x4*)(kvb + (size_t)row * KVB_LD + h * 256 + 128 + 8 * pc); }
            __syncthreads();
            const int s = c * 64 + F.lane; const bool valid = s <= t;
            float d = 0.f;
#pragma unroll 6
            for (int pc = 0; pc < 24; ++pc) { const h16x8 kv = *(const LAS h16x8*)(k_l + F.lane * KROW + 8 * pc); const h16x8 qv = *(const LAS h16x8*)(q_l + 8 * pc);
#pragma unroll
                for (int e = 0; e < 4; ++e) { h16x2 qa, ka; qa.x = qv[2 * e]; qa.y = qv[2 * e + 1]; ka.x = kv[2 * e]; ka.y = kv[2 * e + 1]; d = __builtin_amdgcn_fdot2(qa, ka, d, false); } }
            const float lgt = valid ? d * scale : -INFINITY;
            const float mn = fmaxf(mx, wave_max(lgt));
            const float corr = __expf(mx - mn); const float p = __expf(lgt - mn);
            l = l * corr + wave_sum(p); o0 *= corr; o1 *= corr; mx = mn;
#pragma unroll 8
            for (int j = 0; j < 64; ++j) { const float pj = __shfl(p, j); const h16x2 v = *(const LAS h16x2*)(v_l + j * 128 + 2 * F.lane); o0 += pj * (float)v.x; o1 += pj * (float)v.y; }
        }
        const float inv = 1.0f / l;
        *(unsigned*)(ocat + (size_t)m * D + 768 + h * 128 + 2 * F.lane) = pkh(o0 * inv, o1 * inv);
    }
    __syncthreads();
}

typedef float f32x16 __attribute__((ext_vector_type(16)));
typedef short s16x4v __attribute__((__vector_size__(4 * sizeof(short))));
__device__ __forceinline__ h16x4 lds_tr_read(LAS unsigned char* p) { s16x4v r = __builtin_amdgcn_ds_read_tr16_b64_v4i16((LAS s16x4v*)p); return __builtin_bit_cast(h16x4, r); }
struct AttnSrc {
    const half_t* q; int q_ld, q_hs;
    const half_t* k0; int k0_ld, k0_hs;
    const half_t* k1; int k1_ld;
    const half_t* v; int v_ld, v_hs;
    half_t* o; int o_ld, o_off;
    int nheads, kv_rows;
    float scale; const float* cs;
};
template <int DQK, bool CAUSAL>
__device__ __forceinline__ void phase_attn_mfma(const Frame& F0, const AttnSrc& T) {
    Frame F = F0; asm volatile("" : "+v"(F.lane)); asm volatile("" : "+v"(F.tid)); asm volatile("" : "+s"(F.wave));
    constexpr int NKS = DQK / 16, KROWB = (DQK == 192) ? 400 : 272, VROWB = 320, KBYTES = 64 * KROWB, VBYTES = 64 * VROWB, BUF = KBYTES + VBYTES;
    constexpr int KPT = DQK / 64, VPT = 2;
    static_assert(2 * BUF <= RING_BYTES, "attention LDS");
    const int lane = F.lane, hh = lane >> 5, l31 = lane & 31, wave = F.wave, tid = F.tid;
    LAS unsigned char* lds = F.lds;
    const float c = T.scale * 1.4426950408889634f;
    const int nbh = BATCH * T.nheads, nunits = nbh * 8;
    const int sr = tid >> 3, sp0 = tid & 7;
    const int trofs = (4 * hh + ((lane & 15) >> 2)) * VROWB + (16 * ((lane >> 4) & 1) + 4 * (lane & 3)) * 2;
    const int kofs = l31 * KROWB + 16 * hh;
#pragma unroll 1
    for (int round = 0;; ++round) {
        int u;
        if (CAUSAL && F.G == 256 && nunits == 384) { if (round == 0) u = blockIdx.x; else if (round == 1 && blockIdx.x >= 128) u = 511 - (int)blockIdx.x; else break; }
        else { u = blockIdx.x + round * F.G; if (u >= nunits) break; }
        const int qblk = CAUSAL ? 7 - u / nbh : u / nbh; const int bh = u % nbh; const int b = bh / T.nheads, h = bh % T.nheads;
        const int R0 = 256 * qblk + 32 * wave;
        const size_t mrow = (size_t)b * SEQ + R0 + l31;
        h16x8 qf[NKS];
        { const half_t* qp = T.q + mrow * T.q_ld + h * T.q_hs + 8 * hh;
#pragma unroll
          for (int ks = 0; ks < NKS; ++ks) qf[ks] = *(const h16x8*)(qp + 16 * ks); }
        if (DQK == 192) {
            const float* csr = T.cs + mrow * 64;
#pragma unroll
            for (int a = 0; a < 2; ++a)
#pragma unroll
                for (int j = 0; j < 8; ++j) { const int idx = 16 * a + 8 * hh + j; const float cv = csr[idx], sv = csr[32 + idx]; const float x1 = (float)qf[8 + a][j], x2 = (float)qf[10 + a][j];
                    qf[8 + a][j] = (half_t)(x1 * cv - x2 * sv); qf[10 + a][j] = (half_t)(x1 * sv + x2 * cv); }
        }
        f32x16 o[4];
#pragma unroll
        for (int dt = 0; dt < 4; ++dt)
#pragma unroll
            for (int r = 0; r < 16; ++r) o[dt][r] = 0.f;
        float mrun = -INFINITY, lsum = 0.f;
        const int ntiles = CAUSAL ? 4 * (qblk + 1) : T.kv_rows / 64;
        const int my_last = CAUSAL ? 4 * qblk + (wave >> 1) : ntiles - 1;
        const size_t kvrow0 = (size_t)b * T.kv_rows;
        u32x4 kreg[KPT], vreg[VPT];
#define ATT_ISSUE(j) do { const size_t row = kvrow0 + 64 * (j) + sr; const half_t* pk0 = T.k0 + row * T.k0_ld + h * T.k0_hs + 8 * sp0; const half_t* pk1 = (DQK == 192) ? T.k1 + row * T.k1_ld + 8 * sp0 : pk0; \
            const half_t* pv = T.v + row * T.v_ld + h * T.v_hs + 8 * sp0; \
            _Pragma("unroll") for (int k = 0; k < KPT; ++k) kreg[k] = (k < 2) ? *(const u32x4*)(pk0 + 64 * k) : *(const u32x4*)(pk1); \
            _Pragma("unroll") for (int k = 0; k < VPT; ++k) vreg[k] = *(const u32x4*)(pv + 64 * k); } while (0)
#define ATT_WRITE(buf) do { LAS unsigned char* wb = lds + (buf) * BUF + sp0 * 16; _Pragma("unroll") for (int k = 0; k < KPT; ++k) *(LAS u32x4*)(wb + sr * KROWB + k * 128) = kreg[k]; \
        _Pragma("unroll") for (int k = 0; k < VPT; ++k) *(LAS u32x4*)(wb + KBYTES + sr * VROWB + k * 128) = vreg[k]; } while (0)
        __syncthreads();
        ATT_ISSUE(0); ATT_WRITE(0);
        __syncthreads();
#pragma unroll 1
        for (int j = 0; j < ntiles; ++j) {
            const int buf = j & 1;
            if (j + 1 < ntiles) ATT_ISSUE(j + 1);
            if (j <= my_last) {
                LAS unsigned char* kb = lds + buf * BUF;
                f32x16 s0, s1;
#pragma unroll
                for (int r = 0; r < 16; ++r) { s0[r] = 0.f; s1[r] = 0.f; }
#pragma unroll
                for (int ks = 0; ks < NKS; ++ks) {
                    const h16x8 a0 = *(const LAS h16x8*)(kb + kofs + ks * 32), a1 = *(const LAS h16x8*)(kb + kofs + 32 * KROWB + ks * 32);
                    s0 = __builtin_amdgcn_mfma_f32_32x32x16_f16(a0, qf[ks], s0, 0, 0, 0);
                    s1 = __builtin_amdgcn_mfma_f32_32x32x16_f16(a1, qf[ks], s1, 0, 0, 0);
                }
                if (CAUSAL && j == my_last) {
                    const int qi = R0 + l31, k0i = 64 * j + 4 * hh;
#pragma unroll
                    for (int r = 0; r < 16; ++r) { const int key = k0i + 8 * (r >> 2) + (r & 3); if (key > qi) s0[r] = -INFINITY; if (key + 32 > qi) s1[r] = -INFINITY; }
                }
                float mx = fmaxf(s0[0], s1[0]);
#pragma unroll
                for (int r = 1; r < 16; ++r) mx = fmaxf(mx, fmaxf(s0[r], s1[r]));
                mx = fmaxf(mx, __shfl_xor(mx, 32));
                const float mnew = fmaxf(mrun, mx); const float alpha = __builtin_amdgcn_exp2f((mrun - mnew) * c); mrun = mnew; const float mc = mnew * c;
                float ps = 0.f;
#pragma unroll
                for (int r = 0; r < 16; ++r) { s0[r] = __builtin_amdgcn_exp2f(s0[r] * c - mc); s1[r] = __builtin_amdgcn_exp2f(s1[r] * c - mc); ps += s0[r] + s1[r]; }
                lsum = lsum * alpha + ps;
#pragma unroll
                for (int dt = 0; dt < 4; ++dt)
#pragma unroll
                    for (int r = 0; r < 16; ++r) o[dt][r] *= alpha;
                h16x8 pf[4];
#pragma unroll
                for (int sp = 0; sp < 4; ++sp)
#pragma unroll
                    for (int j2 = 0; j2 < 8; ++j2) pf[sp][j2] = (half_t)((sp >> 1) ? s1[8 * (sp & 1) + j2] : s0[8 * (sp & 1) + j2]);
                LAS unsigned char* vb = kb + KBYTES + trofs;
#pragma unroll
                for (int sp = 0; sp < 4; ++sp)
#pragma unroll
                    for (int dt = 0; dt < 4; ++dt) {
                        const h16x4 x = lds_tr_read(vb + sp * 16 * VROWB + dt * 64), y = lds_tr_read(vb + (sp * 16 + 8) * VROWB + dt * 64);
                        h16x8 av; av[0] = x[0]; av[1] = x[1]; av[2] = x[2]; av[3] = x[3]; av[4] = y[0]; av[5] = y[1]; av[6] = y[2]; av[7] = y[3];
                        o[dt] = __builtin_amdgcn_mfma_f32_32x32x16_f16(av, pf[sp], o[dt], 0, 0, 0);
                    }
            }
            if (j + 1 < ntiles) ATT_WRITE(buf ^ 1);
            __syncthreads();
        }
#undef ATT_ISSUE
#undef ATT_WRITE
        const float ltot = lsum + __shfl_xor(lsum, 32); const float inv = 1.0f / ltot;
        half_t* op = T.o + mrow * T.o_ld + T.o_off + h * 128 + 4 * hh;
#pragma unroll
        for (int dt = 0; dt < 4; ++dt)
#pragma unroll
            for (int g = 0; g < 4; ++g) { u32x2 w; w.x = pkh(o[dt][4 * g] * inv, o[dt][4 * g + 1] * inv); w.y = pkh(o[dt][4 * g + 2] * inv, o[dt][4 * g + 3] * inv);
                *(u32x2*)(op + 32 * dt + 8 * g) = w; }
    }
    __syncthreads();
}

constexpr int NP = 13, NPH = 2 + DEPTH * NP;
typedef const Args __attribute__((address_space(4))) CArgs;
#define SITE_PTRS() CArgs* ap = kap; asm volatile("" : "+s"(ap)); unsigned char* ws = ap->ws; (void)ws
__global__ void __launch_bounds__(NTHREADS, 2) fwd_kernel(Args args) {
    extern __shared__ __attribute__((aligned(16))) unsigned char lds_raw[];
    CArgs* kap = (CArgs*)__builtin_amdgcn_kernarg_segment_ptr();
    Frame F;
    F.lds = (LAS unsigned char*)lds_raw;
    F.tid = threadIdx.x; F.lane = F.tid & 63; F.wave = __builtin_amdgcn_readfirstlane(F.tid >> 6);
    F.G = gridDim.x; F.gw = blockIdx.x * NWAVES + F.wave; F.NGW = F.G * NWAVES; F.ws = nullptr;
    volatile LAS unsigned* ctl_l = (volatile LAS unsigned*)(F.lds + LDSCTL_OFF);
    for (int u = F.tid; u < (LDS_BYTES - LDSCTL_OFF) / 4; u += NTHREADS) ctl_l[u] = 0u;
    __syncthreads();
    const int lo = args.ph_lo, hi = args.ph_hi;
    XcdBarrier bar; bar.bar = (unsigned*)(args.ws + WS_CTL) + CW_BAR; bar.x = 0; bar.st = ctl_l + 8;
    if (hi - lo > 1) {
        bar = xcd_barrier_post((unsigned*)(args.ws + WS_CTL) + CW_BAR, ctl_l + 8);
        if (threadIdx.x == 0) { unsigned nloc, nx; xcd_barrier_complete(bar.bar, bar.x, nloc, nx); bar.st[0] = nloc; bar.st[1] = nx; }
        __syncthreads();
    }
#define IN(k) (lo <= (k) && (k) < hi)
#define SEAM(k) do { if (IN((k) + 1)) xcd_barrier(bar); } while (0)
#define P_X16 ((half_t*)(ws + WS_X16))
#define P_PROJ ((half_t*)(ws + WS_R1))
#define P_H16 ((half_t*)(ws + WS_R1))
#define P_PRELN ((float*)(ws + WS_R1 + R1_PRELN))
#define P_OCAT ((half_t*)(ws + WS_OCAT))
#define P_QB ((half_t*)(ws + WS_QB))
#define P_KVB ((half_t*)(ws + WS_KVB))
#define P_LATN ((half_t*)(ws + WS_LATN))
#define P_KROPE ((half_t*)(ws + WS_KROPE))
#define P_TMPF ((float*)(ws + WS_TMP))
#define P_SEL ((unsigned short*)(ws + WS_SEL))
#define P_CS ((const float*)(ws + WS_CS))
#define P_MEMKV ((half_t*)(ws + WS_MEMKV))
#define P_LUT ((const int*)(ws + WS_LUT))
#define P_LW (ws + WS_W + (size_t)l * LW_END)

#ifndef NO_PRO
    if (IN(0)) { SITE_PTRS(); F.ws = ws; phase_prologue(F, ap); SEAM(0); }
#endif
    if (IN(1)) {
        SITE_PTRS();
        pg8::Gemm g{(const half_t*)(ws + WS_MEM16), (const half_t*)(ws + WS_WMEM), D, D, D}; pg8::StaticOrder S; S.init(BATCH * MEML, 4096, F.G, (int)blockIdx.x);
        pg8::EpiH16 E; E.O = P_MEMKV; E.ldc = 4096; E.sig_from = 1 << 30;
        pg8::gemm_phase(F.lds, g, S, E);
        SEAM(1);
    }
#pragma unroll 1
    for (int l = 0; l < DEPTH; ++l) {
        const int p0 = 2 + l * NP;
        if (p0 + NP <= lo || p0 >= hi) continue;
        if (IN(p0 + 0)) {
            SITE_PTRS();
            pg8::Gemm g{P_X16, (const half_t*)(P_LW + LW_UP1), D, D, D}; pg8::StaticOrder S; S.init(M, 2 * DFF, F.G, (int)blockIdx.x);
            pg8::EpiSwiglu E; E.H = P_H16; E.ldh = DFF;
            pg8::gemm_phase(F.lds, g, S, E); SEAM(p0 + 0);
        }
        if (IN(p0 + 1)) {
            SITE_PTRS();
            pg8::Gemm g{P_H16, (const half_t*)(P_LW + LW_DN1), DFF, DFF, DFF}; pg8::StaticOrder S; S.init(M, D, F.G, (int)blockIdx.x);
            pg8::EpiResid E; E.X = (l == 0) ? (const float*)ap->in[0] : ap->out; E.O = P_PRELN; E.alpha = ALPHA; E.coef = 0.5f;
            pg8::gemm_phase(F.lds, g, S, E); SEAM(p0 + 1);
        }
        if (IN(p0 + 2)) { SITE_PTRS(); phase_ln(F, P_PRELN, (const float*)ap->in[4] + (size_t)l * 3 * D, (const float*)ap->in[5] + (size_t)l * 3 * D, ap->out, P_X16); SEAM(p0 + 2); }
        if (IN(p0 + 3)) {
            SITE_PTRS();
            pg8::Gemm g{P_X16, (const half_t*)(P_LW + LW_IN), D, D, D}; pg8::StaticOrder S; S.init(M, PROJ_LD, F.G, (int)blockIdx.x);
            pg8::EpiH16 E; E.O = P_PROJ; E.ldc = PROJ_LD; E.sig_from = PC_GATES / 256;
            pg8::gemm_phase(F.lds, g, S, E); SEAM(p0 + 3);
        }
        if (IN(p0 + 4)) {
            SITE_PTRS();
#ifndef NO_P5
            phase_p5(F, P_PROJ, (const float*)ap->in[9] + (size_t)l * QL, (const float*)ap->in[10] + (size_t)l * KVL, P_LATN, P_KROPE, P_CS, P_SEL);
            __syncthreads();
            phase_indexer(F, P_PROJ, P_SEL);
#endif
            SEAM(p0 + 4);
        }
        if (IN(p0 + 5)) {
            { SITE_PTRS(); pg8::Gemm g{P_LATN, (const half_t*)(P_LW + LW_UQ), LATN_LD, QL, QL}; pg8::StaticOrder S; S.init(M, QB_LD, F.G, (int)blockIdx.x);
              pg8::EpiH16 E; E.O = P_QB; E.ldc = QB_LD; E.sig_from = 1 << 30; pg8::gemm_phase(F.lds, g, S, E); }
            { SITE_PTRS(); pg8::Gemm g{P_LATN + 512, (const half_t*)(P_LW + LW_UKV), LATN_LD, KVL, KVL}; pg8::StaticOrder S; S.init(M, KVB_LD, F.G, (int)blockIdx.x);
              pg8::EpiH16 E; E.O = P_KVB; E.ldc = KVB_LD; E.sig_from = 1 << 30; pg8::gemm_phase(F.lds, g, S, E); }
            SEAM(p0 + 5);
        }
        if (IN(p0 + 6)) {
#ifndef NO_GA
            { SITE_PTRS(); phase_gattn<A_HEADS, true>(F, P_PROJ, P_MEMKV, P_SEL, (const int*)ap->in[2], (const float*)ap->in[3], P_LUT, P_OCAT); }
#endif
#ifndef NO_GC
            { SITE_PTRS(); AttnSrc T; T.q = P_PROJ + PC_CQ; T.q_ld = PROJ_LD; T.q_hs = 128; T.k0 = P_MEMKV + (size_t)l * 1024; T.k0_ld = 4096; T.k0_hs = 128; T.k1 = nullptr; T.k1_ld = 0;
              T.v = P_MEMKV + (size_t)l * 1024 + 512; T.v_ld = 4096; T.v_hs = 128; T.o = P_OCAT; T.o_ld = D; T.o_off = 1536; T.nheads = C_HEADS; T.kv_rows = MEML; T.scale = 0.08838834764831845f; T.cs = nullptr;
              phase_attn_mfma<128, false>(F, T); }
#endif
            __syncthreads();
#ifndef NO_BA
            { SITE_PTRS(); AttnSrc T; T.q = P_QB; T.q_ld = QB_LD; T.q_hs = 192; T.k0 = P_KVB; T.k0_ld = KVB_LD; T.k0_hs = 256; T.k1 = P_KROPE; T.k1_ld = ROPE;
              T.v = P_KVB + 128; T.v_ld = KVB_LD; T.v_hs = 256; T.o = P_OCAT; T.o_ld = D; T.o_off = 768; T.nheads = B_HEADS; T.kv_rows = SEQ; T.scale = 0.07216878364870322f; T.cs = P_CS;
              phase_attn_mfma<192, true>(F, T); }
#endif
            SEAM(p0 + 6);
        }
        if (IN(p0 + 7)) {
            { SITE_PTRS(); pg8::Gemm g{P_OCAT, (const half_t*)(P_LW + LW_BR), D, D, 768}; pg8::StaticOrder S; S.init(M, D, F.G, (int)blockIdx.x);
              pg8::EpiBranch<0> E; E.G = P_PROJ + PC_GATES; E.ldg = PROJ_LD; E.T = P_TMPF; E.O = P_X16; pg8::gemm_phase(F.lds, g, S, E); }
            { SITE_PTRS(); pg8::Gemm g{P_OCAT + 768, (const half_t*)(P_LW + LW_BR) + 768, D, D, 768}; pg8::StaticOrder S; S.init(M, D, F.G, (int)blockIdx.x);
              pg8::EpiBranch<1> E; E.G = P_PROJ + PC_GATES + D; E.ldg = PROJ_LD; E.T = P_TMPF; E.O = P_X16; pg8::gemm_phase(F.lds, g, S, E); }
            { SITE_PTRS(); pg8::Gemm g{P_OCAT + 1536, (const half_t*)(P_LW + LW_BR) + 1536, D, D, 512}; pg8::StaticOrder S; S.init(M, D, F.G, (int)blockIdx.x);
              pg8::EpiBranch<2> E; E.G = P_PROJ + PC_GATES + 2 * D; E.ldg = PROJ_LD; E.T = P_TMPF; E.O = P_X16; pg8::gemm_phase(F.lds, g, S, E); }
            SEAM(p0 + 7);
        }
        if (IN(p0 + 8)) {
            SITE_PTRS();
            pg8::Gemm g{P_X16, (const half_t*)(P_LW + LW_OUT), D, D, D}; pg8::StaticOrder S; S.init(M, D, F.G, (int)blockIdx.x);
            pg8::EpiResid E; E.X = ap->out; E.O = P_PRELN; E.alpha = ALPHA; E.coef = 1.0f;
            pg8::gemm_phase(F.lds, g, S, E); SEAM(p0 + 8);
        }
        if (IN(p0 + 9)) { SITE_PTRS(); phase_ln(F, P_PRELN, (const float*)ap->in[4] + (size_t)l * 3 * D + D, (const float*)ap->in[5] + (size_t)l * 3 * D + D, ap->out, P_X16); SEAM(p0 + 9); }
        if (IN(p0 + 10)) {
            SITE_PTRS();
            pg8::Gemm g{P_X16, (const half_t*)(P_LW + LW_UP2), D, D, D}; pg8::StaticOrder S; S.init(M, 2 * DFF, F.G, (int)blockIdx.x);
            pg8::EpiSwiglu E; E.H = P_H16; E.ldh = DFF;
            pg8::gemm_phase(F.lds, g, S, E); SEAM(p0 + 10);
        }
        if (IN(p0 + 11)) {
            SITE_PTRS();
            pg8::Gemm g{P_H16, (const half_t*)(P_LW + LW_DN2), DFF, DFF, DFF}; pg8::StaticOrder S; S.init(M, D, F.G, (int)blockIdx.x);
            pg8::EpiResid E; E.X = ap->out; E.O = P_PRELN; E.alpha = ALPHA; E.coef = 0.5f;
            pg8::gemm_phase(F.lds, g, S, E); SEAM(p0 + 11);
        }
        if (IN(p0 + 12)) { SITE_PTRS(); phase_ln(F, P_PRELN, (const float*)ap->in[4] + (size_t)l * 3 * D + 2 * D, (const float*)ap->in[5] + (size_t)l * 3 * D + 2 * D, ap->out, P_X16); SEAM(p0 + 12); }
    }
#undef IN
#undef SEAM
}

extern "C" void kernel_launch(void* const* d_in, const int* in_sizes, int n_in, void* d_out, int out_size, void* d_ws, size_t ws_size, hipStream_t stream) {
    static int grid = 0;
    if (grid == 0) {
        if (n_in != 18 || out_size != M * D || ws_size < WS_END) { fprintf(stderr, "kernel_launch: unexpected shapes (n_in %d out %d ws %zu need %zu)\n", n_in, out_size, ws_size, (size_t)WS_END); grid = -1; return; }
        int dev = 0, cus = 0, per_cu = 0;
        if (hipGetDevice(&dev) != hipSuccess || hipDeviceGetAttribute(&cus, hipDeviceAttributeMultiprocessorCount, dev) != hipSuccess) { grid = -1; return; }
        if (hipFuncSetAttribute((const void*)fwd_kernel, hipFuncAttributeMaxDynamicSharedMemorySize, LDS_BYTES) != hipSuccess) { fprintf(stderr, "kernel_launch: hipFuncSetAttribute failed\n"); grid = -1; return; }
        if (hipOccupancyMaxActiveBlocksPerMultiprocessor(&per_cu, (const void*)fwd_kernel, NTHREADS, LDS_BYTES) != hipSuccess || per_cu < 1) { fprintf(stderr, "kernel_launch: occupancy query says %d\n", per_cu); }
        (void)hipGetLastError();
        grid = cus;
    }
    if (grid < 0) return;
    (void)hipMemsetAsync((char*)d_ws + WS_CTL, 0, CTL_ZERO_BYTES, stream);
    Args a{};
    for (int i = 0; i < 18; ++i) a.in[i] = d_in[i];
    a.out = (float*)d_out; a.ws = (unsigned char*)d_ws;
#if ONE_LAUNCH
    a.ph_lo = 0; a.ph_hi = NPH;
    hipLaunchKernelGGL(fwd_kernel, dim3(grid), dim3(NTHREADS), LDS_BYTES, stream, a);
#else
    for (int p = 0; p < NPH; ++p) { a.ph_lo = p; a.ph_hi = p + 1; hipLaunchKernelGGL(fwd_kernel, dim3(grid), dim3(NTHREADS), LDS_BYTES, stream, a); }
#endif
}
```

```cpp
#include <hip/hip_runtime.h>
#include <cstdio>
#include <cstdint>

#ifndef REP_UP
#define REP_UP 1
#endif
#ifndef REP_GA
#define REP_GA 1
#endif
#ifndef REP_PRO
#define REP_PRO 1
#endif
#ifndef REP_LN
#define REP_LN 1
#endif
#ifndef REP_BA
#define REP_BA 1
#endif
#ifndef REP_IDX
#define REP_IDX 1
#endif
#ifndef ONE_LAUNCH
#define ONE_LAUNCH 1
#endif

#define GAS __attribute__((address_space(1)))
#define LAS __attribute__((address_space(3)))
typedef _Float16 half_t;
typedef _Float16 h16x8 __attribute__((ext_vector_type(8)));
typedef _Float16 h16x4 __attribute__((ext_vector_type(4)));
typedef _Float16 h16x2 __attribute__((ext_vector_type(2)));
typedef float f32x4 __attribute__((ext_vector_type(4)));
typedef float f32x2 __attribute__((ext_vector_type(2)));
typedef unsigned u32x4 __attribute__((ext_vector_type(4)));
typedef unsigned u32x2 __attribute__((ext_vector_type(2)));
typedef int i32x4 __attribute__((ext_vector_type(4)));

constexpr int D = 2048, BATCH = 8, SEQ = 2048, M = BATCH * SEQ, DEPTH = 4, MEML = 256, HD = 128;
constexpr int A_HEADS = 6, IDX_HEADS = 16, IDX_DIM = 64, TOPK = 256, B_HEADS = 6, QL = 512, KVL = 512, NOPE = 128, ROPE = 64, VD = 128, C_HEADS = 4;
constexpr int DFF = 5632, IN_COLS = 9872, PROJ_LD = 9984;
constexpr int QB_LD = 1280, KVB_LD = 1536, LATN_LD = 1024;
constexpr float LN_EPS = 1e-5f, RMS_EPS = 1e-6f;
constexpr float ALPHA = 1.681792830507429f;
constexpr int PC_AQ = 0, PC_AK = 768, PC_AV = 896, PC_IQ = 1024, PC_IK = 2048, PC_KR = 2112, PC_IW = 2176, PC_CQL = 2304, PC_CKVL = 2816, PC_CQ = 3328, PC_GATES = 3840;
constexpr int NWAVES = 8, NTHREADS = 512;

constexpr size_t al256(size_t x) { return (x + 255) & ~(size_t)255; }
constexpr size_t WS_CTL = 0, CTL_ZERO_BYTES = 1u << 20;
constexpr size_t SZ_WUP = (size_t)2 * DFF * D * 2, SZ_WDN = (size_t)D * DFF * 2, SZ_WIN = (size_t)PROJ_LD * D * 2, SZ_WUQ = (size_t)QB_LD * QL * 2, SZ_WUKV = (size_t)KVB_LD * KVL * 2;
constexpr size_t SZ_WBR = (size_t)D * D * 2, SZ_WOUT = (size_t)D * D * 2;
constexpr size_t LW_UP1 = 0, LW_DN1 = LW_UP1 + SZ_WUP, LW_IN = LW_DN1 + SZ_WDN, LW_UQ = LW_IN + SZ_WIN, LW_UKV = LW_UQ + SZ_WUQ, LW_BR = LW_UKV + SZ_WUKV, LW_OUT = LW_BR + SZ_WBR,
                 LW_UP2 = LW_OUT + SZ_WOUT, LW_DN2 = LW_UP2 + SZ_WUP, LW_END = LW_DN2 + SZ_WDN;
constexpr size_t WS_W = CTL_ZERO_BYTES;
constexpr size_t WS_WMEM = WS_W + (size_t)DEPTH * LW_END;
constexpr size_t WS_X16 = WS_WMEM + (size_t)DEPTH * 1024 * D * 2;
constexpr size_t WS_R1 = WS_X16 + (size_t)M * D * 2;
constexpr size_t R1_PRELN = (size_t)M * DFF * 2;
constexpr size_t WS_OCAT = WS_R1 + (size_t)M * PROJ_LD * 2;
constexpr size_t WS_QB = WS_OCAT + (size_t)M * D * 2;
constexpr size_t WS_KVB = WS_QB + (size_t)M * QB_LD * 2;
constexpr size_t WS_LATN = WS_KVB + (size_t)M * KVB_LD * 2;
constexpr size_t WS_KROPE = WS_LATN + (size_t)M * LATN_LD * 2;
constexpr size_t WS_TMP = WS_KROPE + (size_t)M * ROPE * 2;
constexpr size_t WS_SEL = WS_TMP + (size_t)M * D * 4;
constexpr size_t WS_CS = WS_SEL + (size_t)M * TOPK * 2;
constexpr size_t WS_MEM16 = WS_CS + (size_t)M * 64 * 4;
constexpr size_t WS_MEMKV = WS_MEM16 + (size_t)BATCH * MEML * D * 2;
constexpr size_t WS_LUT = WS_MEMKV + (size_t)BATCH * MEML * 4096 * 2;
constexpr size_t WS_SELM = WS_LUT + 1024;
constexpr size_t WS_END = WS_SELM + (size_t)M * 32 * 8;
static_assert(R1_PRELN + (size_t)M * D * 4 <= (size_t)M * PROJ_LD * 2, "preLN fits behind h16");
static_assert(WS_W % 256 == 0 && LW_END % 256 == 0, "align");

constexpr int CW_BAR = 4096;

constexpr int RING_BYTES = 131072, LDSCTL_OFF = RING_BYTES, LDS_BYTES = 147456;

#define LDS_WAIT() asm volatile("s_waitcnt lgkmcnt(0)" ::: "memory")
#define VM_WAIT() asm volatile("s_waitcnt vmcnt(0)" ::: "memory")
__device__ __forceinline__ unsigned pkh(float lo, float hi) { h16x2 v; v.x = (half_t)lo; v.y = (half_t)hi; return __builtin_bit_cast(unsigned, v); }
__device__ __forceinline__ float wave_sum(float v) {
#pragma unroll
    for (int o = 1; o < 64; o <<= 1) v += __shfl_xor(v, o);
    return v;
}
__device__ __forceinline__ float wave_max(float v) {
#pragma unroll
    for (int o = 1; o < 64; o <<= 1) v = fmaxf(v, __shfl_xor(v, o));
    return v;
}
__device__ __forceinline__ float xshfl_f(float v, int mask, int lane) { return __builtin_bit_cast(float, __builtin_amdgcn_ds_bpermute((lane ^ mask) << 2, __builtin_bit_cast(int, v))); }
__device__ __forceinline__ int xshfl_i(int v, int mask, int lane) { return __builtin_amdgcn_ds_bpermute((lane ^ mask) << 2, v); }
__device__ __forceinline__ float fast_sigmoid(float x) { return __builtin_amdgcn_rcpf(1.0f + __builtin_amdgcn_exp2f(-1.4426950408889634f * x)); }

__device__ __forceinline__ int lane_id() { return (int)__builtin_amdgcn_mbcnt_hi(~0u, __builtin_amdgcn_mbcnt_lo(~0u, 0u)); }
#define XB_TMO      128
#define XB_XCNT(j)  (256  + 64 * (j))
#define XB_XSUB(j)  (1280 + 64 * (j))
#define XB_XGEN(j)  (2304 + 64 * (j))
#define XB_TOP      3328
#define XB_TOPGEN   3392
#define XCD_BAR_WORDS 3456
#define XB_SPIN_CAP (1u << 20)
__device__ __forceinline__ unsigned xb_ld(unsigned* p)              { return __hip_atomic_load(p, __ATOMIC_RELAXED, __HIP_MEMORY_SCOPE_AGENT); }
__device__ __forceinline__ unsigned xb_add(unsigned* p, unsigned v) { return __hip_atomic_fetch_add(p, v, __ATOMIC_RELAXED, __HIP_MEMORY_SCOPE_AGENT); }
__device__ __forceinline__ unsigned xb_xcc_id() { return (unsigned)__builtin_amdgcn_s_getreg((3 << 11) | 20) & 0xFu; }
#define XB_SPIN(cond, bar) do { unsigned _sp = 0; while (cond) { __builtin_amdgcn_s_sleep(1); \
    if ((++_sp & 255u) == 0u) { if (xb_ld(&(bar)[XB_TMO])) break; if (_sp > XB_SPIN_CAP) { atomicAdd(&(bar)[XB_TMO], 1u); break; } } } } while (0)
struct XcdBarrier { unsigned* bar; unsigned x; volatile LAS unsigned* st; int wave; };
#define xb_is_t0() (b.wave == 0 && __builtin_amdgcn_mbcnt_hi(~0u, __builtin_amdgcn_mbcnt_lo(~0u, 0u)) == 0u)
__device__ __forceinline__ XcdBarrier xcd_barrier_post(unsigned* bar, volatile LAS unsigned* st, int wave) {
    XcdBarrier b; b.bar = bar; b.x = xb_xcc_id(); b.st = st; b.wave = wave;
    if (xb_is_t0()) (void)xb_add(&bar[XB_XCNT(b.x)], 1u);
    return b;
}
__device__ __forceinline__ void xcd_barrier_complete(unsigned* bar, unsigned x, unsigned& nloc, unsigned& nx) {
    const unsigned G = gridDim.x * gridDim.y * gridDim.z;
    unsigned sum, cnt, mine, sp = 0u;
    for (;;) {
        sum = 0u; cnt = 0u; mine = 0u;
#pragma unroll
        for (unsigned j = 0; j < 16; ++j) { const unsigned c = xb_ld(&bar[XB_XCNT(j)]); sum += c; cnt += (c > 0u) ? 1u : 0u; mine = (j == x) ? c : mine; }
        if (sum == G) break;
        __builtin_amdgcn_s_sleep(1);
        if ((++sp & 255u) == 0u) { if (xb_ld(&bar[XB_TMO])) break; if (sp > XB_SPIN_CAP) { atomicAdd(&bar[XB_TMO], 1u); break; } }
    }
    nloc = mine > 0u ? mine : 1u; nx = cnt > 0u ? cnt : 1u;
}
__device__ __forceinline__ void xcd_barrier(const XcdBarrier& b) {
    asm volatile("s_waitcnt vmcnt(0)" ::: "memory");
    __syncthreads();
    if (xb_is_t0()) {
        unsigned* bar = b.bar;
        __builtin_amdgcn_s_waitcnt(0);
        const unsigned nloc = b.st[0], nx = b.st[1];
        const unsigned old = xb_add(&bar[XB_XSUB(b.x)], 1u);
        const unsigned gen = old / nloc;
        if (old + 1u == (gen + 1u) * nloc) {
            __builtin_amdgcn_fence(__ATOMIC_RELEASE, "agent");
            asm volatile("s_waitcnt vmcnt(0)" ::: "memory");
            const unsigned og = xb_add(&bar[XB_TOP], 1u);
            const unsigned tg = og / nx;
            if (og + 1u == (tg + 1u) * nx) xb_add(&bar[XB_TOPGEN], 1u);
            else XB_SPIN(xb_ld(&bar[XB_TOPGEN]) == tg, bar);
            __builtin_amdgcn_fence(__ATOMIC_ACQUIRE, "agent");
            xb_add(&bar[XB_XGEN(b.x)], 1u);
            asm volatile("s_waitcnt vmcnt(0)" ::: "memory");
        } else {
            XB_SPIN(xb_ld(&bar[XB_XGEN(b.x)]) == gen, bar);
            __builtin_amdgcn_fence(__ATOMIC_ACQUIRE, "agent");
            asm volatile("s_waitcnt vmcnt(0)" ::: "memory");
        }
    }
    __syncthreads();
}

namespace pg8 {
constexpr int BM = 256, BK = 64, HALF = 128, HTB = HALF * BK * 2, STAGE_BYTES = 8 * HTB, NXCD = 8, WGM = 8;
__host__ __device__ __forceinline__ int lds_byte(int r, int c) { const int st = (r >> 4) * 2 + (c >> 5), rr = r & 15, cc = c & 31, ob = rr * 64 + cc * 2; return st * 1024 + (ob ^ (((ob >> 9) & 1) << 5)); }
__host__ __device__ __forceinline__ void stage_rc(int b, int& R, int& C) { const int st = b / 1024, sb = b % 1024, swz = sb ^ (((sb >> 9) & 1) << 5); R = (st >> 1) * 16 + swz / 64; C = (st & 1) * 32 + (swz % 64) / 2; }
__host__ __device__ __forceinline__ int perm32(int rho) { const int n = rho >> 4, i = rho & 15; return 8 * (i >> 2) + 4 * n + (i & 3); }
struct Unit { int pm, pn; };
struct Gemm { const half_t* A; const half_t* Bt; int lda, ldb, K; };
struct StaticOrder {
    int nM, nN, nwg, G, c;
    __host__ __device__ void init(int M_, int N_, int G_, int c_) { nM = M_ / BM; nN = N_ / BM; nwg = nM * nN; G = G_; c = c_; }
    __host__ __device__ bool next(int i, Unit& u) const {
        const long L = (long)i * G + c; if (L >= nwg) return false;
        int wgid = (int)L; { const int q = nwg / NXCD, r = nwg % NXCD, xcd = wgid % NXCD, off = wgid / NXCD; wgid = (xcd < r ? xcd * (q + 1) : r * (q + 1) + (xcd - r) * q) + off; }
        const int nig = WGM * nN, gid = wgid / nig, fm = gid * WGM, gsz = (nM - fm) < WGM ? (nM - fm) : WGM;
        u.pm = fm + ((wgid % nig) % gsz); u.pn = (wgid % nig) / gsz; return true;
    }
};
template <class Epi>
__device__ __forceinline__ void gemm_phase(LAS unsigned char* lds, const Gemm g, const StaticOrder& S0, const Epi& E, int wave_) {
    StaticOrder S = S0; asm volatile("" : "+s"(S.c));
    int w_ = wave_; asm volatile("" : "+s"(w_)); int tid_ = w_ * 64 + lane_id(); asm volatile("" : "+v"(tid_));
    const int tid = tid_, wid = __builtin_amdgcn_readfirstlane(tid >> 6), lane = tid & 63, wr = wid >> 2, wc = wid & 3, fr = lane & 15, fq = lane >> 4;
    const int K = g.K, nt = K / BK;
    unsigned voffA[2], voffB[2];
#pragma unroll
    for (int i = 0; i < 2; ++i) { int R, C; stage_rc(tid * 16 + i * 8192, R, C); const int Rb = Epi::PERM ? ((R & ~31) + perm32(R & 31)) : R;
        voffA[i] = (unsigned)(R * g.lda + C) * 2u; voffB[i] = (unsigned)(Rb * g.ldb + C) * 2u; }
    const size_t kstep = (size_t)(BK * 2);
    const size_t hstepA = (size_t)HALF * g.lda * 2, hstepB = (size_t)HALF * g.ldb * 2;
    const size_t tstepA = 2 * hstepA, tstepB = 2 * hstepB;
    const unsigned ldsw = (unsigned)wid * 1024u;
    const int aoff = lds_byte(wr * 64 + fr, fq * 8), boff = lds_byte(wc * 32 + fr, fq * 8);
#define PG8_SA(b, h) (((b) * 2 + (h)) * HTB)
#define PG8_SB(b, h) ((4 + (b) * 2 + (h)) * HTB)
#define PG8_STAGE(bufoff, gbase, voff) do { _Pragma("unroll") for (int _i = 0; _i < 2; ++_i) \
        __builtin_amdgcn_global_load_lds((const unsigned*)((const char*)(gbase) + (voff)[_i]), (LAS unsigned*)(lds + (bufoff) + ldsw + _i * 8192), 16, 0, 0); } while (0)
#define PG8_LDA(dst, b, h) do { _Pragma("unroll") for (int m = 0; m < 4; ++m) _Pragma("unroll") for (int k = 0; k < 2; ++k) dst[m][k] = *(const LAS h16x8*)(lds + PG8_SA(b, h) + aoff + m * 2048 + k * 1024); } while (0)
#define PG8_LDB(dst, b, h) do { _Pragma("unroll") for (int n = 0; n < 2; ++n) _Pragma("unroll") for (int k = 0; k < 2; ++k) dst[n][k] = *(const LAS h16x8*)(lds + PG8_SB(b, h) + boff + n * 2048 + k * 1024); } while (0)
#define PG8_MMA(ai, bj, At, Bt) do { __builtin_amdgcn_s_setprio(1); _Pragma("unroll") for (int m = 0; m < 4; ++m) _Pragma("unroll") for (int n = 0; n < 2; ++n) _Pragma("unroll") for (int k = 0; k < 2; ++k) \
        acc[ai][bj][m][n] = __builtin_amdgcn_mfma_f32_16x16x32_f16(Bt[n][k], At[m][k], acc[ai][bj][m][n], 0, 0, 0); __builtin_amdgcn_s_setprio(0); } while (0)
#define PG8_WAIT_V(n) asm volatile("s_waitcnt vmcnt(" #n ")" ::: "memory")
#define PG8_WAIT_L(n) asm volatile("s_waitcnt lgkmcnt(" #n ")" ::: "memory")
#define PG8_BAR __builtin_amdgcn_s_barrier()
#define PG8_SCHED __builtin_amdgcn_sched_barrier(0)
    Unit cur, nxt; int ui = 0;
    if (!S.next(0, cur)) return;
    f32x4 acc[2][2][4][2];
#pragma unroll
    for (int a = 0; a < 2; ++a)
#pragma unroll
        for (int b = 0; b < 2; ++b)
#pragma unroll
            for (int m = 0; m < 4; ++m)
#pragma unroll
                for (int n = 0; n < 2; ++n) acc[a][b][m][n] = (f32x4){0.f, 0.f, 0.f, 0.f};
    h16x8 At[4][2], B0[2][2], B1[2][2];
    const char* cA = (const char*)g.A + (size_t)cur.pm * tstepA; const char* cB = (const char*)g.Bt + (size_t)cur.pn * tstepB;
    PG8_STAGE(PG8_SB(0, 0), cB, voffB); PG8_STAGE(PG8_SB(0, 1), cB + hstepB, voffB); PG8_STAGE(PG8_SA(0, 0), cA, voffA); PG8_STAGE(PG8_SA(0, 1), cA + hstepA, voffA);
    if (wr == 1) PG8_BAR;
    PG8_WAIT_V(2); PG8_BAR;
    PG8_STAGE(PG8_SB(1, 0), cB + kstep, voffB); PG8_STAGE(PG8_SA(1, 0), cA + kstep, voffA); PG8_STAGE(PG8_SB(1, 1), cB + hstepB + kstep, voffB);
    PG8_WAIT_V(6); PG8_BAR;
    for (;;) {
        const bool has_next = S.next(ui + 1, nxt);
        const char* nA = has_next ? (const char*)g.A + (size_t)nxt.pm * tstepA : cA; const char* nB = has_next ? (const char*)g.Bt + (size_t)nxt.pn * tstepB : cB;
        for (int t = 0; t < nt; t += 2) {
            const bool last = (t == nt - 2);
            const char* a1 = cA + (size_t)(t + 1) * kstep;
            const char* a2 = last ? nA : cA + (size_t)(t + 2) * kstep; const char* b2 = last ? nB : cB + (size_t)(t + 2) * kstep;
            const char* a3 = a2 + kstep; const char* b3 = b2 + kstep;
            E.mid(acc, cur, t, wr, wc, fr, fq);
            PG8_LDB(B0, 0, 0); PG8_LDB(B1, 0, 1); PG8_SCHED; PG8_LDA(At, 0, 0); PG8_STAGE(PG8_SA(1, 1), a1 + hstepA, voffA);
            PG8_WAIT_V(8); PG8_WAIT_L(0); PG8_BAR; PG8_MMA(0, 0, At, B0); PG8_MMA(0, 1, At, B1); PG8_BAR; PG8_SCHED;
            PG8_LDA(At, 0, 1); PG8_STAGE(PG8_SB(0, 0), b2, voffB); PG8_STAGE(PG8_SB(0, 1), b2 + hstepB, voffB); PG8_STAGE(PG8_SA(0, 0), a2, voffA);
            PG8_WAIT_V(8); PG8_WAIT_L(0); PG8_BAR; PG8_MMA(1, 0, At, B0); PG8_MMA(1, 1, At, B1); PG8_BAR; PG8_SCHED;
            PG8_LDB(B0, 1, 0); PG8_LDB(B1, 1, 1); PG8_SCHED; PG8_LDA(At, 1, 0); PG8_STAGE(PG8_SA(0, 1), a2 + hstepA, voffA);
            PG8_WAIT_V(8); PG8_WAIT_L(0); PG8_BAR; PG8_MMA(0, 0, At, B0); PG8_MMA(0, 1, At, B1); PG8_BAR; PG8_SCHED;
            PG8_LDA(At, 1, 1); PG8_STAGE(PG8_SB(1, 0), b3, voffB); PG8_STAGE(PG8_SB(1, 1), b3 + hstepB, voffB); PG8_STAGE(PG8_SA(1, 0), a3, voffA);
            PG8_WAIT_V(8); PG8_WAIT_L(0); PG8_BAR; PG8_MMA(1, 0, At, B0); PG8_MMA(1, 1, At, B1); PG8_BAR; PG8_SCHED;
        }
        if (wr == 0) PG8_BAR;
        E(acc, cur, wr, wc, fr, fq);
        if (!has_next) break;
#pragma unroll
        for (int a = 0; a < 2; ++a)
#pragma unroll
            for (int b = 0; b < 2; ++b)
#pragma unroll
                for (int m = 0; m < 4; ++m)
#pragma unroll
                    for (int n = 0; n < 2; ++n) acc[a][b][m][n] = (f32x4){0.f, 0.f, 0.f, 0.f};
        cur = nxt; cA = nA; cB = nB; ++ui;
        if (wr == 1) PG8_BAR;
    }
    PG8_WAIT_V(0);
    PG8_BAR;
#undef PG8_SA
#undef PG8_SB
#undef PG8_STAGE
#undef PG8_LDA
#undef PG8_LDB
#undef PG8_MMA
#undef PG8_WAIT_V
#undef PG8_WAIT_L
#undef PG8_BAR
#undef PG8_SCHED
}

typedef f32x4 Acc[2][2][4][2];
struct EpiBase { __device__ __forceinline__ void mid(Acc&, const Unit&, int, int, int, int, int) const {} };
struct EpiSwiglu : EpiBase {
    static constexpr bool PERM = true;
    half_t* H; int ldh;
    __device__ __forceinline__ void operator()(const Acc& acc, const Unit& u, int wr, int wc, int fr, int fq) const {
        const int row0 = u.pm * BM + wr * 64 + fr, col0 = u.pn * 128 + wc * 32 + 8 * fq;
#pragma unroll
        for (int ai = 0; ai < 2; ++ai)
#pragma unroll
            for (int m = 0; m < 4; ++m) {
                half_t* rowp = H + (size_t)(row0 + ai * HALF + m * 16) * ldh + col0;
                float o[8];
#pragma unroll
                for (int n = 0; n < 2; ++n)
#pragma unroll
                    for (int j = 0; j < 4; ++j) { const float gt = acc[ai][0][m][n][j], up = acc[ai][1][m][n][j]; o[n * 4 + j] = gt * fast_sigmoid(gt) * up; }
                u32x4 w; w.x = pkh(o[0], o[1]); w.y = pkh(o[2], o[3]); w.z = pkh(o[4], o[5]); w.w = pkh(o[6], o[7]);
                *(u32x4*)rowp = w;
            }
    }
};
struct EpiResid : EpiBase {
    static constexpr bool PERM = false;
    const float* X; float* O; float alpha, coef;
    __device__ __forceinline__ void operator()(const Acc& acc, const Unit& u, int wr, int wc, int fr, int fq) const {
        const int row0 = u.pm * BM + wr * 64 + fr, col0 = u.pn * BM + wc * 32 + 4 * fq;
#pragma unroll
        for (int ai = 0; ai < 2; ++ai)
#pragma unroll
            for (int m = 0; m < 4; ++m) { const size_t off = (size_t)(row0 + ai * HALF + m * 16) * D + col0;
#pragma unroll
                for (int bj = 0; bj < 2; ++bj)
#pragma unroll
                    for (int n = 0; n < 2; ++n) { const f32x4 xv = *(const f32x4*)(X + off + bj * HALF + n * 16);
                        *(f32x4*)(O + off + bj * HALF + n * 16) = xv * alpha + acc[ai][bj][m][n] * coef; }
                asm volatile("" ::: "memory"); }
    }
};
struct EpiH16 : EpiBase {
    static constexpr bool PERM = true;
    half_t* O; int ldc; int sig_from;
    __device__ __forceinline__ void operator()(const Acc& acc, const Unit& u, int wr, int wc, int fr, int fq) const {
        const int row0 = u.pm * BM + wr * 64 + fr, col0 = u.pn * BM + wc * 32 + 8 * fq;
        const bool sg = u.pn >= sig_from;
#pragma unroll
        for (int ai = 0; ai < 2; ++ai)
#pragma unroll
            for (int m = 0; m < 4; ++m) { half_t* rowp = O + (size_t)(row0 + ai * HALF + m * 16) * ldc + col0;
#pragma unroll
                for (int bj = 0; bj < 2; ++bj) { f32x4 v0 = acc[ai][bj][m][0], v1 = acc[ai][bj][m][1];
                    if (sg) {
#pragma unroll
                        for (int j = 0; j < 4; ++j) { v0[j] = fast_sigmoid(v0[j]); v1[j] = fast_sigmoid(v1[j]); } }
                    u32x4 w; w.x = pkh(v0[0], v0[1]); w.y = pkh(v0[2], v0[3]); w.z = pkh(v1[0], v1[1]); w.w = pkh(v1[2], v1[3]);
                    *(u32x4*)(rowp + bj * HALF) = w; } }
    }
};
template <int MODE> struct EpiBranch : EpiBase {
    static constexpr bool PERM = false;
    const half_t* G; int ldg; float* T; half_t* O;
    __device__ __forceinline__ void operator()(const Acc& acc, const Unit& u, int wr, int wc, int fr, int fq) const {
        const int row0 = u.pm * BM + wr * 64 + fr, col0 = u.pn * BM + wc * 32 + 4 * fq;
#pragma unroll
        for (int ai = 0; ai < 2; ++ai)
#pragma unroll
            for (int m = 0; m < 4; ++m) { const int row = row0 + ai * HALF + m * 16; const size_t off = (size_t)row * D + col0;
#pragma unroll
                for (int bj = 0; bj < 2; ++bj)
#pragma unroll
                    for (int n = 0; n < 2; ++n) { const int co = bj * HALF + n * 16;
                        const h16x4 gv = *(const h16x4*)(G + (size_t)row * ldg + col0 + co);
                        f32x4 v = acc[ai][bj][m][n]; v[0] *= (float)gv[0]; v[1] *= (float)gv[1]; v[2] *= (float)gv[2]; v[3] *= (float)gv[3];
                        if (MODE >= 1) v += *(const f32x4*)(T + off + co);
                        if (MODE <= 1) *(f32x4*)(T + off + co) = v;
                        else { u32x2 w; w.x = pkh(v[0], v[1]); w.y = pkh(v[2], v[3]); *(u32x2*)(O + off + co) = w; } }
                asm volatile("" ::: "memory"); }
    }
};
}

enum { PX_X16 = 0, PX_R1, PX_PRELN, PX_OCAT, PX_QB, PX_KVB, PX_LATN, PX_KROPE, PX_TMPF, PX_SEL, PX_CS, PX_MEMKV, PX_LUT, PX_SELM, PX_MEM16, PX_WMEM, PX_N };
enum { LWX_UP1 = 0, LWX_DN1, LWX_IN, LWX_UQ, LWX_UKV, LWX_BR, LWX_OUT, LWX_UP2, LWX_DN2, LWX_N };
struct Args { const void* in[18]; float* out; unsigned char* ws; unsigned char* p[PX_N]; unsigned char* lw[DEPTH][LWX_N]; int ph_lo, ph_hi; };
struct Frame {
    LAS unsigned char* lds;
    int tid, lane, wave, G, gw, NGW;
    unsigned char* ws;
};

__device__ __forceinline__ Frame make_frame(int wave) {
    extern __shared__ __attribute__((aligned(16))) unsigned char lds_raw[];
    Frame F; F.lds = (LAS unsigned char*)lds_raw; F.wave = __builtin_amdgcn_readfirstlane(wave); asm volatile("" : "+s"(F.wave)); F.lane = lane_id(); F.tid = F.wave * 64 + F.lane;
    F.G = gridDim.x; F.gw = blockIdx.x * NWAVES + F.wave; F.NGW = F.G * NWAVES; F.ws = nullptr; return F;
}
typedef const struct Args __attribute__((address_space(4))) CArgs;
__device__ __forceinline__ int map_col(int kind, int n, float& scale) {
    scale = 1.f;
    if (kind == 0) return n;
    if (kind == 1) { if (n < DFF) return 256 * (n >> 7) + (n & 127); const int q = n - DFF; return 256 * (q >> 7) + 128 + (q & 127); }
    if (n < 2112) return n;
    if (n < 2128) { scale = 1.0f / 32.0f; return n + 64; }
    if (n < 3152) return n + 176;
    if (n < 3216) return n - 1040;
    return n + 112;
}
__device__ __forceinline__ void transpose_item(const float* W, int K, int N, half_t* WT, int kind, LAS float* scr, int item, int lane) {
    const int nblk = (N + 31) / 32, kb = item / nblk, nb = item % nblk, k0 = 64 * kb, n0 = 32 * nb;
    const int nl = (n0 + (lane & 31) < N) ? n0 + (lane & 31) : N - 1;
#pragma unroll 8
    for (int i = 0; i < 32; ++i) { const int kk = 2 * i + (lane >> 5); scr[kk * 33 + (lane & 31)] = W[(size_t)(k0 + kk) * N + nl]; }
    LDS_WAIT(); asm volatile("" ::: "memory");
    const int c = lane & 7;
#pragma unroll
    for (int j = 0; j < 4; ++j) { const int nn = (lane >> 3) + 8 * j; const int n = n0 + nn;
        if (n < N) { float sc; const int dr = map_col(kind, n, sc); const LAS float* s = scr + (8 * c) * 33 + nn;
            u32x4 o; o.x = pkh(s[0 * 33] * sc, s[1 * 33] * sc); o.y = pkh(s[2 * 33] * sc, s[3 * 33] * sc); o.z = pkh(s[4 * 33] * sc, s[5 * 33] * sc); o.w = pkh(s[6 * 33] * sc, s[7 * 33] * sc);
            *(u32x4*)(WT + (size_t)dr * K + k0 + 8 * c) = o; } }
    LDS_WAIT(); asm volatile("" ::: "memory");
}
__device__ __forceinline__ void cvt_f32_to_h16(const float* src, half_t* dst, size_t n8, size_t i0, size_t stride) {
    for (size_t i = i0; i < n8; i += stride) { const f32x4 a = *(const f32x4*)(src + i * 8), b = *(const f32x4*)(src + i * 8 + 4);
        u32x4 o; o.x = pkh(a[0], a[1]); o.y = pkh(a[2], a[3]); o.z = pkh(b[0], b[1]); o.w = pkh(b[2], b[3]); *(u32x4*)(dst + i * 8) = o; }
}

__device__ __forceinline__ void sincos_f32arg(float ang, float& c, float& s) {
    const double x = (double)ang; const double k = __builtin_rint(x * 0.15915494309189535); const double r = x - k * 6.283185307179586; const double r2 = r * r;
    double ts = r, sn = r, tc = 1.0, cn = 1.0;
#pragma unroll 1
    for (int i = 1; i <= 14; ++i) { ts *= -r2 / (double)((2 * i) * (2 * i + 1)); sn += ts; tc *= -r2 / (double)((2 * i - 1) * (2 * i)); cn += tc; }
    c = (float)cn; s = (float)sn;
}
#define PRO_JOB(Wp, Kv, Nv, WTp, kindv) do { const float* _W = (Wp); half_t* _WT = (WTp); const int _nitems = ((Kv) / 64) * (((Nv) + 31) / 32); \
    for (int it = F.gw; it < _nitems; it += F.NGW) transpose_item(_W, (Kv), (Nv), _WT, (kindv), scr, it, F.lane); } while (0)
__device__ __forceinline__ void phase_prologue(const Frame& F0, const Args __attribute__((address_space(4)))* argsp) {
    Frame F = F0; asm volatile("" : "+v"(F.lane)); asm volatile("" : "+s"(F.gw));
#define args (*argsp)
    LAS float* scr = (LAS float*)(F.lds + F.wave * 16384);
    unsigned char* ws = F.ws;
#pragma unroll 1
    for (int l = 0; l < DEPTH; ++l) {
        unsigned char* lw = ws + WS_W + (size_t)l * LW_END;
        PRO_JOB((const float*)args.in[6] + (size_t)l * D * 2 * DFF, D, 2 * DFF, (half_t*)(lw + LW_UP1), 1);
        PRO_JOB((const float*)args.in[7] + (size_t)l * DFF * D, DFF, D, (half_t*)(lw + LW_DN1), 0);
        PRO_JOB((const float*)args.in[8] + (size_t)l * D * IN_COLS, D, IN_COLS, (half_t*)(lw + LW_IN), 2);
        PRO_JOB((const float*)args.in[11] + (size_t)l * QL * 1152, QL, 1152, (half_t*)(lw + LW_UQ), 0);
        PRO_JOB((const float*)args.in[12] + (size_t)l * KVL * 1536, KVL, 1536, (half_t*)(lw + LW_UKV), 0);
        PRO_JOB((const float*)args.in[14] + (size_t)l * D * D, D, D, (half_t*)(lw + LW_BR), 0);
        PRO_JOB((const float*)args.in[15] + (size_t)l * D * D, D, D, (half_t*)(lw + LW_OUT), 0);
        PRO_JOB((const float*)args.in[16] + (size_t)l * D * 2 * DFF, D, 2 * DFF, (half_t*)(lw + LW_UP2), 1);
        PRO_JOB((const float*)args.in[17] + (size_t)l * DFF * D, DFF, D, (half_t*)(lw + LW_DN2), 0);
        PRO_JOB((const float*)args.in[13] + (size_t)l * D * 1024, D, 1024, (half_t*)(ws + WS_WMEM) + (size_t)l * 1024 * D, 0);
        { u32x4 z = {0u, 0u, 0u, 0u}; const size_t gt = (size_t)F.gw * 64 + F.lane, gs = (size_t)F.NGW * 64;
          u32x4* p1 = (u32x4*)((half_t*)(lw + LW_IN) + (size_t)2192 * D); for (size_t i = gt; i < (size_t)112 * D / 8; i += gs) p1[i] = z;
          u32x4* p2 = (u32x4*)((half_t*)(lw + LW_UQ) + (size_t)1152 * QL); for (size_t i = gt; i < (size_t)128 * QL / 8; i += gs) p2[i] = z; }
    }
    const size_t gt = (size_t)F.gw * 64 + F.lane, gs = (size_t)F.NGW * 64;
    cvt_f32_to_h16((const float*)args.in[0], (half_t*)(ws + WS_X16), (size_t)M * D / 8, gt, gs);
    cvt_f32_to_h16((const float*)args.in[1], (half_t*)(ws + WS_MEM16), (size_t)BATCH * MEML * D / 8, gt, gs);
    { const int* pos = (const int*)args.in[2]; float* cs = (float*)(ws + WS_CS);
      for (size_t i = gt; i < (size_t)M * 32; i += gs) { const int m = (int)(i >> 5), f = (int)(i & 31);
          double v = 1.0; for (int q = 0; q < f; ++q) v *= 0.7498942093324559;
          const float inv_freq = (float)v; const float ang = (float)pos[m] * inv_freq; float c, s; sincos_f32arg(ang, c, s);
          cs[(size_t)m * 64 + f] = c; cs[(size_t)m * 64 + 32 + f] = s; } }
    if (F.gw == 0) { int* lut = (int*)(ws + WS_LUT);
#undef args
        for (int n = F.lane; n <= 128; n += 64) { int bkt; if (n < 16) bkt = n; else { const float lg2 = __builtin_amdgcn_logf((float)n * (1.0f / 16.0f)); int lg = 16 + (int)(lg2 * (16.0f / 3.0f)); bkt = lg < 31 ? lg : 31; } lut[n] = bkt; } }
}

__device__ __forceinline__ void phase_ln(const Frame& F0, const float* pre, const float* g, const float* b, float* xout, half_t* x16) {
    Frame F = F0; asm volatile("" : "+v"(F.lane)); asm volatile("" : "+s"(F.gw));
    for (int m = F.gw; m < M; m += F.NGW) {
        const f32x4* xr = (const f32x4*)(pre + (size_t)m * D) + F.lane;
        f32x4 v[8]; float s = 0.f;
#pragma unroll
        for (int j = 0; j < 8; ++j) { v[j] = xr[64 * j]; s += (v[j][0] + v[j][1]) + (v[j][2] + v[j][3]); }
        const float mean = wave_sum(s) * (1.f / D); float s2 = 0.f;
#pragma unroll
        for (int j = 0; j < 8; ++j) { v[j] = v[j] - mean; s2 += (v[j][0] * v[j][0] + v[j][1] * v[j][1]) + (v[j][2] * v[j][2] + v[j][3] * v[j][3]); }
        const float rstd = 1.0f / sqrtf(wave_sum(s2) * (1.f / D) + LN_EPS);
#pragma unroll
        for (int j = 0; j < 8; ++j) { const int c = 4 * (F.lane + 64 * j); const f32x4 gg = *(const f32x4*)(g + c), bb = *(const f32x4*)(b + c);
            const f32x4 o = v[j] * rstd * gg + bb;
            *(f32x4*)(xout + (size_t)m * D + c) = o;
            u32x2 w; w.x = pkh(o[0], o[1]); w.y = pkh(o[2], o[3]); *(u32x2*)(x16 + (size_t)m * D + c) = w; }
    }
}

__device__ __forceinline__ unsigned sortable(float f) { f = f + 0.0f; unsigned u = __builtin_bit_cast(unsigned, f); return (u & 0x80000000u) ? ~u : (u | 0x80000000u); }
__device__ __forceinline__ void phase_p5(const Frame& F0, const half_t* proj, const float* qn, const float* kvn, half_t* latn, half_t* krope, const float* cs, unsigned short* sel) {
    Frame F = F0; asm volatile("" : "+v"(F.lane)); asm volatile("" : "+s"(F.gw));
    for (int m = F.gw; m < M; m += F.NGW) {
        const half_t* pr = proj + (size_t)m * PROJ_LD;
#pragma unroll
        for (int w = 0; w < 2; ++w) {
            const h16x8 v = *(const h16x8*)(pr + (w ? PC_CKVL : PC_CQL) + 8 * F.lane);
            float f[8], s = 0.f;
#pragma unroll
            for (int j = 0; j < 8; ++j) { f[j] = (float)v[j]; s += f[j] * f[j]; }
            const float r = 1.0f / sqrtf(wave_sum(s) * (1.f / 512.f) + RMS_EPS);
            const float* gp = (w ? kvn : qn) + 8 * F.lane;
            u32x4 o; o.x = pkh(f[0] * r * gp[0], f[1] * r * gp[1]); o.y = pkh(f[2] * r * gp[2], f[3] * r * gp[3]); o.z = pkh(f[4] * r * gp[4], f[5] * r * gp[5]); o.w = pkh(f[6] * r * gp[6], f[7] * r * gp[7]);
            *(u32x4*)(latn + (size_t)m * LATN_LD + w * 512 + 8 * F.lane) = o;
        }
        if (F.lane < 32) { const float x1 = (float)pr[PC_KR + F.lane], x2 = (float)pr[PC_KR + 32 + F.lane]; const float c = cs[(size_t)m * 64 + F.lane], s = cs[(size_t)m * 64 + 32 + F.lane];
            krope[(size_t)m * ROPE + F.lane] = (half_t)(x1 * c - x2 * s); krope[(size_t)m * ROPE + 32 + F.lane] = (half_t)(x1 * s + x2 * c); }
    }
}
__device__ __forceinline__ void phase_indexer(const Frame& F0, const half_t* proj, unsigned short* sel, unsigned long long* selm) {
    Frame F = F0; asm volatile("" : "+v"(F.lane)); asm volatile("" : "+v"(F.tid)); asm volatile("" : "+s"(F.wave));
    const int lane = F.lane, tid = F.tid, wave = F.wave, g4 = lane >> 4, l15 = lane & 15, hi = lane >> 5, mid = (lane >> 4) & 1;
    LAS unsigned char* lds = F.lds;
    constexpr int CHB = 256 * 128;
    const int srow = tid >> 1, spc = (tid & 1) * 4;
    int bid = blockIdx.x; asm volatile("" : "+s"(bid));
#pragma unroll 1
    for (int gi = bid; gi < BATCH * 256; gi += F.G) {
        const int b = gi >> 8, rr = gi & 255, tg = (b & 1) ? 255 - rr : rr;
        const int t0 = 8 * tg, t = t0 + wave, m = b * SEQ + t, nk = t + 1;
        unsigned short* so = sel + (size_t)m * TOPK; unsigned long long* sm = selm + (size_t)m * 32;
        if (t0 < TOPK) {
            for (int j = lane; j < TOPK; j += 64) so[j] = (unsigned short)(j < nk ? j : 0);
            if (lane < 32) { const int lo_ = 64 * lane; sm[lane] = (nk >= lo_ + 64) ? ~0ull : (nk > lo_ ? ((1ull << (nk - lo_)) - 1ull) : 0ull); }
            continue;
        }
        const half_t* pr = proj + (size_t)m * PROJ_LD;
        h16x8 af[2]; float w4[4];
#pragma unroll
        for (int ks = 0; ks < 2; ++ks) af[ks] = *(const h16x8*)(pr + PC_IQ + l15 * 64 + 32 * ks + 8 * g4);
#pragma unroll
        for (int r = 0; r < 4; ++r) w4[r] = (float)pr[PC_IW + 4 * g4 + r];
        float sc[32];
#pragma unroll
        for (int j = 0; j < 32; ++j) sc[j] = 0.f;
        const int nch = (t0 + 7) / 256 + 1;
        u32x4 kreg[4];
        const half_t* kbase = proj + (size_t)(b * SEQ + srow) * PROJ_LD + PC_IK + 8 * spc;
#define IDX_ISSUE(ch) do { const half_t* kp = kbase + (size_t)(ch) * 256 * PROJ_LD; _Pragma("unroll") for (int k = 0; k < 4; ++k) kreg[k] = *(const u32x4*)(kp + 8 * k); } while (0)
#define IDX_WRITE(buf) do { _Pragma("unroll") for (int k = 0; k < 4; ++k) *(LAS u32x4*)(lds + (buf) * CHB + srow * 128 + (((spc + k) ^ ((srow >> 1) & 7)) << 4)) = kreg[k]; } while (0)
        __syncthreads();
        IDX_ISSUE(0); IDX_WRITE(0);
        __syncthreads();
#pragma unroll
        for (int g = 0; g < 8; ++g) {
            if (g < nch) {
                if (g + 1 < nch) IDX_ISSUE(g + 1);
                LAS unsigned char* cb = lds + (g & 1) * CHB;
#pragma unroll
                for (int q = 0; q < 4; ++q) {
                    float p[4];
#pragma unroll
                    for (int k4 = 0; k4 < 4; ++k4) {
                        const int row = 16 * (4 * q + k4) + l15; const int sw = (row >> 1) & 7;
                        const h16x8 b0 = *(const LAS h16x8*)(cb + row * 128 + ((g4 ^ sw) << 4)), b1 = *(const LAS h16x8*)(cb + row * 128 + (((g4 + 4) ^ sw) << 4));
                        f32x4 d = {0.f, 0.f, 0.f, 0.f};
                        d = __builtin_amdgcn_mfma_f32_16x16x32_f16(af[0], b0, d, 0, 0, 0);
                        d = __builtin_amdgcn_mfma_f32_16x16x32_f16(af[1], b1, d, 0, 0, 0);
                        p[k4] = (w4[0] * fmaxf(d[0], 0.f) + w4[1] * fmaxf(d[1], 0.f)) + (w4[2] * fmaxf(d[2], 0.f) + w4[3] * fmaxf(d[3], 0.f));
                    }
                    const float sendA = hi ? p[0] : p[2], sendB = hi ? p[1] : p[3];
                    const float keepA = (hi ? p[2] : p[0]) + xshfl_f(sendA, 32, lane), keepB = (hi ? p[3] : p[1]) + xshfl_f(sendB, 32, lane);
                    const float send = mid ? keepA : keepB;
                    sc[4 * g + q] = (mid ? keepB : keepA) + xshfl_f(send, 16, lane);
                }
                if (g + 1 < nch) IDX_WRITE((g + 1) & 1);
                __syncthreads();
            }
        }
#undef IDX_ISSUE
#undef IDX_WRITE
        unsigned u[32];
#pragma unroll
        for (int j = 0; j < 32; ++j) { const int s = 64 * j + lane; u[j] = (s < nk) ? sortable(sc[j]) : 0u; }
        unsigned prefix = 0u;
        for (int bit = 31; bit >= 0; --bit) { const unsigned cand = prefix | (1u << bit); int cnt = 0;
#pragma unroll
            for (int j = 0; j < 32; ++j) cnt += __popcll(__ballot(u[j] >= cand));
            if (cnt >= TOPK) prefix = cand; }
        int cgt = 0;
#pragma unroll
        for (int j = 0; j < 32; ++j) cgt += __popcll(__ballot(u[j] > prefix));
        int need = TOPK - cgt;
        int pos = 0;
        const unsigned long long lt_mask = (1ull << lane) - 1ull;
#pragma unroll
        for (int j = 0; j < 32; ++j) {
            const unsigned long long beq = __ballot(u[j] == prefix);
            const int rank_eq = __popcll(beq & lt_mask);
            const bool pick = (u[j] > prefix) || (u[j] == prefix && rank_eq < need);
            const unsigned long long bp = __ballot(pick);
            if (pick) so[pos + __popcll(bp & lt_mask)] = (unsigned short)(64 * j + lane);
            if (lane == 0) sm[j] = bp;
            pos += __popcll(bp);
            const int neq = __popcll(beq); need = need > neq ? need - neq : 0;
        }
        asm volatile("" ::: "memory");
    }
    __syncthreads();
}

template <int NH, bool IS_A>
__device__ __forceinline__ void phase_gattn(const Frame& F0, const half_t* proj, const half_t* memkv, const unsigned short* sel, const int* pos, const float* relb, const int* lut, half_t* ocat) {
    Frame F = F0; asm volatile("" : "+v"(F.lane)); asm volatile("" : "+s"(F.gw));
    LAS unsigned char* wl = F.lds + F.wave * 16384;
    LAS half_t* q_l = (LAS half_t*)wl;
    LAS float* p_l = (LAS float*)(wl + 2048);
    LAS unsigned* idx_l = (LAS unsigned*)(wl + 2048 + 8192);
    LAS float* rb_l = (LAS float*)(wl + 2048 + 8192 + 1024);
    const float scale = 0.08838834764831845f;
    if (IS_A) { for (int i = F.lane; i < 32 * 8; i += 64) rb_l[i] = ((i & 7) < A_HEADS) ? relb[(i >> 3) * A_HEADS + (i & 7)] : 0.f; }
    for (int m = F.gw; m < M; m += F.NGW) {
        const int b = m / SEQ, t = m % SEQ;
        const int nk = IS_A ? (t + 1 < TOPK ? t + 1 : TOPK) : MEML;
        const half_t* qp = proj + (size_t)m * PROJ_LD + (IS_A ? PC_AQ : PC_CQ);
        for (int i = F.lane; i < NH * 16; i += 64) *(LAS u32x4*)(q_l + 8 * i) = *(const u32x4*)(qp + 8 * i);
        for (int j = F.lane; j < 256; j += 64) idx_l[j] = IS_A ? (unsigned)(b * SEQ + sel[(size_t)m * TOPK + j]) : (unsigned)(b * MEML + j);
        LDS_WAIT(); asm volatile("" ::: "memory");
        const int pq = IS_A ? pos[m] : 0;
        float lg[4][NH];
#pragma unroll
        for (int i = 0; i < 4; ++i) {
            const int j = i * 64 + F.lane; const bool valid = j < nk; const unsigned row = idx_l[valid ? j : 0];
            float bias[NH];
#pragma unroll
            for (int h = 0; h < NH; ++h) bias[h] = 0.f;
            if (IS_A) { int dist = pq - pos[row]; dist = dist < 0 ? 0 : (dist > 128 ? 128 : dist); const int bk = lut[dist];
#pragma unroll
                for (int h = 0; h < NH; ++h) bias[h] = rb_l[bk * 8 + h]; }
            if (IS_A) {
                const half_t* kp = proj + (size_t)row * PROJ_LD + PC_AK;
                float d[NH];
#pragma unroll
                for (int h = 0; h < NH; ++h) d[h] = 0.f;
#pragma unroll 4
                for (int c = 0; c < 16; ++c) { const h16x8 kv = *(const h16x8*)(kp + 8 * c);
#pragma unroll
                    for (int h = 0; h < NH; ++h) { const h16x8 qv = *(const LAS h16x8*)(q_l + h * 128 + 8 * c);
#pragma unroll
                        for (int e = 0; e < 4; ++e) { h16x2 qa, ka; qa.x = qv[2 * e]; qa.y = qv[2 * e + 1]; ka.x = kv[2 * e]; ka.y = kv[2 * e + 1]; d[h] = __builtin_amdgcn_fdot2(qa, ka, d[h], false); } } }
#pragma unroll
                for (int h = 0; h < NH; ++h) lg[i][h] = valid ? d[h] * scale + bias[h] : -INFINITY;
            } else {
#pragma unroll
                for (int h = 0; h < NH; ++h) { const half_t* kp = memkv + (size_t)row * 4096 + h * 128; float d = 0.f;
#pragma unroll 4
                    for (int c = 0; c < 16; ++c) { const h16x8 kv = *(const h16x8*)(kp + 8 * c); const h16x8 qv = *(const LAS h16x8*)(q_l + h * 128 + 8 * c);
#pragma unroll
                        for (int e = 0; e < 4; ++e) { h16x2 qa, ka; qa.x = qv[2 * e]; qa.y = qv[2 * e + 1]; ka.x = kv[2 * e]; ka.y = kv[2 * e + 1]; d = __builtin_amdgcn_fdot2(qa, ka, d, false); } }
                    lg[i][h] = valid ? d * scale : -INFINITY; }
            }
        }
#pragma unroll
        for (int h = 0; h < NH; ++h) {
            float mx = fmaxf(fmaxf(lg[0][h], lg[1][h]), fmaxf(lg[2][h], lg[3][h])); mx = wave_max(mx);
            float e[4], s = 0.f;
#pragma unroll
            for (int i = 0; i < 4; ++i) { e[i] = __expf(lg[i][h] - mx); s += e[i]; }
            s = wave_sum(s); const float inv = 1.0f / s;
#pragma unroll
            for (int i = 0; i < 4; ++i) p_l[(i * 64 + F.lane) * 8 + h] = e[i] * inv;
        }
        LDS_WAIT(); asm volatile("" ::: "memory");
        float o[NH][2];
#pragma unroll
        for (int h = 0; h < NH; ++h) { o[h][0] = 0.f; o[h][1] = 0.f; }
#pragma unroll 4
        for (int j = 0; j < nk; ++j) {
            const unsigned row = __builtin_amdgcn_readfirstlane(idx_l[j]);
            const f32x4 p0 = *(const LAS f32x4*)(p_l + j * 8), p1 = *(const LAS f32x4*)(p_l + j * 8 + 4);
            const float pp[8] = {p0[0], p0[1], p0[2], p0[3], p1[0], p1[1], p1[2], p1[3]};
            if (IS_A) { const h16x2 v = *(const h16x2*)(proj + (size_t)row * PROJ_LD + PC_AV + 2 * F.lane); const float v0 = (float)v.x, v1 = (float)v.y;
#pragma unroll
                for (int h = 0; h < NH; ++h) { o[h][0] += pp[h] * v0; o[h][1] += pp[h] * v1; } }
            else {
#pragma unroll
                for (int h = 0; h < NH; ++h) { const h16x2 v = *(const h16x2*)(memkv + (size_t)row * 4096 + 512 + h * 128 + 2 * F.lane); o[h][0] += pp[h] * (float)v.x; o[h][1] += pp[h] * (float)v.y; } }
        }
        half_t* op = ocat + (size_t)m * D + (IS_A ? 0 : 1536);
#pragma unroll
        for (int h = 0; h < NH; ++h) *(unsigned*)(op + h * 128 + 2 * F.lane) = pkh(o[h][0], o[h][1]);
        asm volatile("" ::: "memory");
    }
}

__device__ __forceinline__ void phase_battn(const Frame& F0, const half_t* qb, const half_t* kvb, const half_t* krope, const float* cs, half_t* ocat) {
    Frame F = F0; asm volatile("" : "+v"(F.lane)); asm volatile("" : "+v"(F.tid)); asm volatile("" : "+s"(F.wave));
    constexpr int KROW = 200;
    LAS half_t* k_l = (LAS half_t*)F.lds;
    LAS half_t* v_l = (LAS half_t*)(F.lds + 25600);
    LAS half_t* q_l = (LAS half_t*)(F.lds + 25600 + 16384) + F.wave * 192;
    const float scale = 0.07216878364870322f;
    const int ntask = BATCH * B_HEADS * (SEQ / 8);
    for (int task = blockIdx.x; task < ntask; task += F.G) {
        const int tt = (SEQ / 8 - 1) - task / (BATCH * B_HEADS); const int bh = task % (BATCH * B_HEADS); const int b = bh / B_HEADS, h = bh % B_HEADS;
        const int t = tt * 8 + F.wave, m = b * SEQ + t;
        { const half_t* qp = qb + (size_t)m * QB_LD + h * 192;
          for (int i = F.lane; i < 128; i += 64) q_l[i] = qp[i];
          if (F.lane < 32) { const float x1 = (float)qp[128 + F.lane], x2 = (float)qp[160 + F.lane]; const float c = cs[(size_t)m * 64 + F.lane], s = cs[(size_t)m * 64 + 32 + F.lane];
              q_l[128 + F.lane] = (half_t)(x1 * c - x2 * s); q_l[160 + F.lane] = (half_t)(x1 * s + x2 * c); } }
        float mx = -INFINITY, l = 0.f, o0 = 0.f, o1 = 0.f;
        const int nchunk = (tt * 8 + 8 + 63) / 64;
        for (int c = 0; c < nchunk; ++c) {
            __syncthreads();
            for (int i = F.tid; i < 64 * 24; i += NTHREADS) { const int r = i / 24, pc = i % 24; const int row = b * SEQ + c * 64 + r;
                const u32x4 v = (pc < 16) ? *(const u32x4*)(kvb + (size_t)row * KVB_LD + h * 256 + 8 * pc) : *(const u32x4*)(krope + (size_t)row * ROPE + 8 * (pc - 16));
                *(LAS u32x4*)(k_l + r * KROW + 8 * pc) = v; }
            for (int i = F.tid; i < 64 * 16; i += NTHREADS) { const int r = i / 16, pc = i % 16; const int row = b * SEQ + c * 64 + r;
                *(LAS u32x4*)(v_l + r * 128 + 8 * pc) = *(const u32x4*)(kvb + (size_t)row * KVB_LD + h * 256 + 128 + 8 * pc); }
            __syncthreads();
            const int s = c * 64 + F.lane; const bool valid = s <= t;
            float d = 0.f;
#pragma unroll 6
            for (int pc = 0; pc < 24; ++pc) { const h16x8 kv = *(const LAS h16x8*)(k_l + F.lane * KROW + 8 * pc); const h16x8 qv = *(const LAS h16x8*)(q_l + 8 * pc);
#pragma unroll
                for (int e = 0; e < 4; ++e) { h16x2 qa, ka; qa.x = qv[2 * e]; qa.y = qv[2 * e + 1]; ka.x = kv[2 * e]; ka.y = kv[2 * e + 1]; d = __builtin_amdgcn_fdot2(qa, ka, d, false); } }
            const float lgt = valid ? d * scale : -INFINITY;
            const float mn = fmaxf(mx, wave_max(lgt));
            const float corr = __expf(mx - mn); const float p = __expf(lgt - mn);
            l = l * corr + wave_sum(p); o0 *= corr; o1 *= corr; mx = mn;
#pragma unroll 8
            for (int j = 0; j < 64; ++j) { const float pj = __shfl(p, j); const h16x2 v = *(const LAS h16x2*)(v_l + j * 128 + 2 * F.lane); o0 += pj * (float)v.x; o1 += pj * (float)v.y; }
        }
        const float inv = 1.0f / l;
        *(unsigned*)(ocat + (size_t)m * D + 768 + h * 128 + 2 * F.lane) = pkh(o0 * inv, o1 * inv);
    }
    __syncthreads();
}

typedef float f32x16 __attribute__((ext_vector_type(16)));
typedef short s16x4v __attribute__((__vector_size__(4 * sizeof(short))));
__device__ __forceinline__ h16x4 lds_tr_read(LAS unsigned char* p) { s16x4v r = __builtin_amdgcn_ds_read_tr16_b64_v4i16((LAS s16x4v*)p); return __builtin_bit_cast(h16x4, r); }
struct AttnSrc {
    const half_t* q; int q_ld, q_hs;
    const half_t* k0; int k0_ld, k0_hs;
    const half_t* k1; int k1_ld;
    const half_t* v; int v_ld, v_hs;
    half_t* o; int o_ld, o_off;
    int nheads, kv_rows;
    float scale; const float* cs;
    const unsigned long long* selm; const int* pos; const float* relb; const int* lut;
};
template <int DQK, bool CAUSAL, int MODE>
__device__ __forceinline__ void phase_attn_mfma(const Frame& F0, const AttnSrc& T) {
    Frame F = F0; asm volatile("" : "+v"(F.lane)); asm volatile("" : "+v"(F.tid)); asm volatile("" : "+s"(F.wave));
    constexpr int NKS = DQK / 16, KROWB = (DQK == 192) ? 400 : 272, VROWB = 320, KBYTES = 64 * KROWB, VBYTES = 64 * VROWB, BUF = KBYTES + VBYTES + 256;
    constexpr int KPT = DQK / 64, VPT = 2;
    constexpr int BL_OFF = 2 * BUF;
    static_assert(2 * BUF + 1024 <= RING_BYTES, "attention LDS");
    const int lane = F.lane, hh = lane >> 5, l31 = lane & 31, wave = F.wave, tid = F.tid;
    int bid = blockIdx.x; asm volatile("" : "+s"(bid));
    LAS unsigned char* lds = F.lds;
    const float c = T.scale * 1.4426950408889634f;
    const int nbh = BATCH * T.nheads, nunits = nbh * 8;
    const int sr = tid >> 3, sp0 = tid & 7;
    const int trofs = (4 * hh + ((lane & 15) >> 2)) * VROWB + (16 * ((lane >> 4) & 1) + 4 * (lane & 3)) * 2;
    const int kofs = l31 * KROWB + 16 * hh;
#pragma unroll 1
    for (int round = 0;; ++round) {
        int u;
        if (CAUSAL && F.G == 256 && nunits == 384) { if (round == 0) u = bid; else if (round == 1 && bid >= 128) u = 511 - bid; else break; }
        else { u = bid + round * F.G; if (u >= nunits) break; }
        const int qblk = CAUSAL ? 7 - u / nbh : u / nbh; const int bh = u % nbh; const int b = bh / T.nheads, h = bh % T.nheads;
        const int R0 = 256 * qblk + 32 * wave;
        const size_t mrow = (size_t)b * SEQ + R0 + l31;
        h16x8 qf[NKS];
        { const half_t* qp = T.q + mrow * T.q_ld + h * T.q_hs + 8 * hh;
#pragma unroll
          for (int ks = 0; ks < NKS; ++ks) qf[ks] = *(const h16x8*)(qp + 16 * ks); }
        if (DQK == 192) {
            const float* csr = T.cs + mrow * 64;
#pragma unroll
            for (int a = 0; a < 2; ++a)
#pragma unroll
                for (int j = 0; j < 8; ++j) { const int idx = 16 * a + 8 * hh + j; const float cv = csr[idx], sv = csr[32 + idx]; const float x1 = (float)qf[8 + a][j], x2 = (float)qf[10 + a][j];
                    qf[8 + a][j] = (half_t)(x1 * cv - x2 * sv); qf[10 + a][j] = (half_t)(x1 * sv + x2 * cv); }
        }
        f32x16 o[4];
#pragma unroll
        for (int dt = 0; dt < 4; ++dt)
#pragma unroll
            for (int r = 0; r < 16; ++r) o[dt][r] = 0.f;
        float mrun = -1e30f, lsum = 0.f;
        const int ntiles = CAUSAL ? 4 * (qblk + 1) : T.kv_rows / 64;
        const int my_last = CAUSAL ? 4 * qblk + (wave >> 1) : ntiles - 1;
        const size_t kvrow0 = (size_t)b * T.kv_rows;
        u32x4 kreg[KPT], vreg[VPT], preg;
        int posq = 0, posq_min = 0; unsigned long long wnext = 0ull; const unsigned long long* selrow = nullptr;
        if (MODE == 1) { posq = T.pos[mrow]; posq_min = posq;
#pragma unroll
            for (int of = 1; of < 64; of <<= 1) { const int other = xshfl_i(posq_min, of, lane); posq_min = other < posq_min ? other : posq_min; }
            selrow = T.selm + mrow * 32; wnext = selrow[0]; }
#define ATT_ISSUE(j) do { const size_t row = kvrow0 + 64 * (j) + sr; const half_t* pk0 = T.k0 + row * T.k0_ld + h * T.k0_hs + 8 * sp0; const half_t* pk1 = (DQK == 192) ? T.k1 + row * T.k1_ld + 8 * sp0 : pk0; \
            const half_t* pv = T.v + row * T.v_ld + h * T.v_hs + 8 * sp0; \
            _Pragma("unroll") for (int k = 0; k < KPT; ++k) kreg[k] = (k < 2) ? *(const u32x4*)(pk0 + 64 * k) : *(const u32x4*)(pk1); \
            _Pragma("unroll") for (int k = 0; k < VPT; ++k) vreg[k] = *(const u32x4*)(pv + 64 * k); \
            if (MODE == 1) preg = *(const u32x4*)(T.pos + kvrow0 + 64 * (j) + 4 * (tid & 15)); } while (0)
#define ATT_WRITE(buf) do { LAS unsigned char* wb = lds + (buf) * BUF + sp0 * 16; _Pragma("unroll") for (int k = 0; k < KPT; ++k) *(LAS u32x4*)(wb + sr * KROWB + k * 128) = kreg[k]; \
        _Pragma("unroll") for (int k = 0; k < VPT; ++k) *(LAS u32x4*)(wb + KBYTES + sr * VROWB + k * 128) = vreg[k]; \
        if (MODE == 1) { if (tid < 16) *(LAS u32x4*)(lds + (buf) * BUF + KBYTES + VBYTES + tid * 16) = preg; } } while (0)
        __syncthreads();
        if (MODE == 1) { if (tid <= 128) ((LAS float*)(lds + BL_OFF))[tid] = T.relb[T.lut[tid] * A_HEADS + h] * 1.4426950408889634f; }
        ATT_ISSUE(0); ATT_WRITE(0);
        __syncthreads();
        const float bl31 = (MODE == 1) ? ((const LAS float*)(lds + BL_OFF))[128] : 0.f;
#pragma unroll 1
        for (int j = 0; j < ntiles; ++j) {
            const int buf = j & 1;
            if (j + 1 < ntiles) ATT_ISSUE(j + 1);
            if (j <= my_last) {
                LAS unsigned char* kb = lds + buf * BUF;
                unsigned long long wsel = 0ull;
                if (MODE == 1) { wsel = wnext; if (j < my_last) wnext = selrow[j + 1]; }
                f32x16 s0, s1;
#pragma unroll
                for (int r = 0; r < 16; ++r) { s0[r] = 0.f; s1[r] = 0.f; }
#pragma unroll
                for (int ks = 0; ks < NKS; ++ks) {
                    const h16x8 a0 = *(const LAS h16x8*)(kb + kofs + ks * 32), a1 = *(const LAS h16x8*)(kb + kofs + 32 * KROWB + ks * 32);
                    s0 = __builtin_amdgcn_mfma_f32_32x32x16_f16(a0, qf[ks], s0, 0, 0, 0);
                    s1 = __builtin_amdgcn_mfma_f32_32x32x16_f16(a1, qf[ks], s1, 0, 0, 0);
                }
                if (MODE == 1) {
                    const LAS int* pk = (const LAS int*)(kb + KBYTES + VBYTES);
                    int pkmax = pk[lane];
#pragma unroll
                    for (int of = 1; of < 64; of <<= 1) { const int other = xshfl_i(pkmax, of, lane); pkmax = other > pkmax ? other : pkmax; }
                    if (posq_min - pkmax >= 128) {
#pragma unroll
                        for (int r = 0; r < 16; ++r) { s0[r] = s0[r] * c + bl31; s1[r] = s1[r] * c + bl31; }
                    } else {
                        const LAS float* bl = (const LAS float*)(lds + BL_OFF);
#pragma unroll
                        for (int g = 0; g < 4; ++g) {
                            const i32x4 pa = *(const LAS i32x4*)(pk + 8 * g + 4 * hh), pb = *(const LAS i32x4*)(pk + 32 + 8 * g + 4 * hh);
                            const int pav[4] = {pa[0], pa[1], pa[2], pa[3]}, pbv[4] = {pb[0], pb[1], pb[2], pb[3]};
#pragma unroll
                            for (int e = 0; e < 4; ++e) { int d0 = posq - pav[e]; d0 = d0 < 0 ? 0 : (d0 > 128 ? 128 : d0); int d1 = posq - pbv[e]; d1 = d1 < 0 ? 0 : (d1 > 128 ? 128 : d1);
                                s0[4 * g + e] = s0[4 * g + e] * c + bl[d0]; s1[4 * g + e] = s1[4 * g + e] * c + bl[d1]; }
                        }
                    }
                    const unsigned wl = (unsigned)(wsel >> (4 * hh)), wh = (unsigned)(wsel >> (32 + 4 * hh));
#pragma unroll
                    for (int r = 0; r < 16; ++r) { const unsigned bitc = 1u << (8 * (r >> 2) + (r & 3)); if (!(wl & bitc)) s0[r] = -INFINITY; if (!(wh & bitc)) s1[r] = -INFINITY; }
                } else {
#pragma unroll
                    for (int r = 0; r < 16; ++r) { s0[r] *= c; s1[r] *= c; }
                    if (CAUSAL && j == my_last) {
                        const int qi = R0 + l31, k0i = 64 * j + 4 * hh;
#pragma unroll
                        for (int r = 0; r < 16; ++r) { const int key = k0i + 8 * (r >> 2) + (r & 3); if (key > qi) s0[r] = -INFINITY; if (key + 32 > qi) s1[r] = -INFINITY; }
                    }
                }
                float mx = fmaxf(s0[0], s1[0]);
#pragma unroll
                for (int r = 1; r < 16; ++r) mx = fmaxf(mx, fmaxf(s0[r], s1[r]));
                mx = fmaxf(mx, xshfl_f(mx, 32, lane));
                const float mnew = fmaxf(mrun, mx); const float alpha = __builtin_amdgcn_exp2f(mrun - mnew); mrun = mnew;
                float ps = 0.f;
#pragma unroll
                for (int r = 0; r < 16; ++r) { s0[r] = __builtin_amdgcn_exp2f(s0[r] - mnew); s1[r] = __builtin_amdgcn_exp2f(s1[r] - mnew); ps += s0[r] + s1[r]; }
                lsum = lsum * alpha + ps;
#pragma unroll
                for (int dt = 0; dt < 4; ++dt)
#pragma unroll
                    for (int r = 0; r < 16; ++r) o[dt][r] *= alpha;
                h16x8 pf[4];
#pragma unroll
                for (int sp = 0; sp < 4; ++sp)
#pragma unroll
                    for (int j2 = 0; j2 < 8; ++j2) pf[sp][j2] = (half_t)((sp >> 1) ? s1[8 * (sp & 1) + j2] : s0[8 * (sp & 1) + j2]);
                LAS unsigned char* vb = kb + KBYTES + trofs;
#pragma unroll
                for (int sp = 0; sp < 4; ++sp)
#pragma unroll
                    for (int dt = 0; dt < 4; ++dt) {
                        const h16x4 x = lds_tr_read(vb + sp * 16 * VROWB + dt * 64), y = lds_tr_read(vb + (sp * 16 + 8) * VROWB + dt * 64);
                        h16x8 av; av[0] = x[0]; av[1] = x[1]; av[2] = x[2]; av[3] = x[3]; av[4] = y[0]; av[5] = y[1]; av[6] = y[2]; av[7] = y[3];
                        o[dt] = __builtin_amdgcn_mfma_f32_32x32x16_f16(av, pf[sp], o[dt], 0, 0, 0);
                    }
            }
            if (j + 1 < ntiles) ATT_WRITE(buf ^ 1);
            __syncthreads();
        }
#undef ATT_ISSUE
#undef ATT_WRITE
        const float ltot = lsum + xshfl_f(lsum, 32, lane); const float inv = 1.0f / ltot;
        half_t* op = T.o + mrow * T.o_ld + T.o_off + h * 128 + 4 * hh;
#pragma unroll
        for (int dt = 0; dt < 4; ++dt)
#pragma unroll
            for (int g = 0; g < 4; ++g) { u32x2 w; w.x = pkh(o[dt][4 * g] * inv, o[dt][4 * g + 1] * inv); w.y = pkh(o[dt][4 * g + 2] * inv, o[dt][4 * g + 3] * inv);
                *(u32x2*)(op + 32 * dt + 8 * g) = w; }
    }
    __syncthreads();
}

constexpr int NP = 13, NPH = 2 + DEPTH * NP;
#define P_X16 ((half_t*)ap->p[PX_X16])
#define P_PROJ ((half_t*)ap->p[PX_R1])
#define P_H16 ((half_t*)ap->p[PX_R1])
#define P_PRELN ((float*)ap->p[PX_PRELN])
#define P_OCAT ((half_t*)ap->p[PX_OCAT])
#define P_QB ((half_t*)ap->p[PX_QB])
#define P_KVB ((half_t*)ap->p[PX_KVB])
#define P_LATN ((half_t*)ap->p[PX_LATN])
#define P_KROPE ((half_t*)ap->p[PX_KROPE])
#define P_TMPF ((float*)ap->p[PX_TMPF])
#define P_SEL ((unsigned short*)ap->p[PX_SEL])
#define P_CS ((const float*)ap->p[PX_CS])
#define P_MEMKV ((half_t*)ap->p[PX_MEMKV])
#define P_LUT ((const int*)ap->p[PX_LUT])
#define P_LWP(k) ((const half_t*)ap->lw[l][k])
#define PH_NOINLINE static __device__ __attribute__((noinline))
static __device__ __forceinline__ void ph_prologue(CArgs* ap, int wv) { Frame F = make_frame(wv); F.ws = ap->ws; for (int rep = 0; rep < REP_PRO; ++rep) phase_prologue(F, ap); }
PH_NOINLINE void ph_ln(CArgs* ap, int l, int which, int wv) {
    Frame F = make_frame(wv); unsigned char* ws = ap->ws;
    for (int rep = 0; rep < REP_LN; ++rep) phase_ln(F, P_PRELN, (const float*)ap->in[4] + (size_t)(l * 3 + which) * D, (const float*)ap->in[5] + (size_t)(l * 3 + which) * D, ap->out, P_X16);
}
PH_NOINLINE void ph_p5(CArgs* ap, int l, int wv) {
    Frame F = make_frame(wv); unsigned char* ws = ap->ws;
    phase_p5(F, P_PROJ, (const float*)ap->in[9] + (size_t)l * QL, (const float*)ap->in[10] + (size_t)l * KVL, P_LATN, P_KROPE, P_CS, P_SEL);
}
static __device__ __forceinline__ void ph_indexer(CArgs* ap, int wv) {
    Frame F = make_frame(wv); unsigned char* ws = ap->ws;
    for (int rep = 0; rep < REP_IDX; ++rep) phase_indexer(F, P_PROJ, P_SEL, (unsigned long long*)ap->p[PX_SELM]);
}
static __device__ __forceinline__ void ph_attn_a(CArgs* ap, int wv) {
    Frame F = make_frame(wv); unsigned char* ws = ap->ws;
    AttnSrc T; T.q = P_PROJ + PC_AQ; T.q_ld = PROJ_LD; T.q_hs = 128; T.k0 = P_PROJ + PC_AK; T.k0_ld = PROJ_LD; T.k0_hs = 0; T.k1 = nullptr; T.k1_ld = 0;
    T.v = P_PROJ + PC_AV; T.v_ld = PROJ_LD; T.v_hs = 0; T.o = P_OCAT; T.o_ld = D; T.o_off = 0; T.nheads = A_HEADS; T.kv_rows = SEQ; T.scale = 0.08838834764831845f; T.cs = nullptr;
    T.selm = (const unsigned long long*)ap->p[PX_SELM]; T.pos = (const int*)ap->in[2]; T.relb = (const float*)ap->in[3]; T.lut = P_LUT;
    phase_attn_mfma<128, true, 1>(F, T);
}
static __device__ __forceinline__ void ph_attn_c(CArgs* ap, int l, int wv) {
    Frame F = make_frame(wv); unsigned char* ws = ap->ws;
    AttnSrc T; T.q = P_PROJ + PC_CQ; T.q_ld = PROJ_LD; T.q_hs = 128; T.k0 = P_MEMKV + (size_t)l * 1024; T.k0_ld = 4096; T.k0_hs = 128; T.k1 = nullptr; T.k1_ld = 0;
    T.v = P_MEMKV + (size_t)l * 1024 + 512; T.v_ld = 4096; T.v_hs = 128; T.o = P_OCAT; T.o_ld = D; T.o_off = 1536; T.nheads = C_HEADS; T.kv_rows = MEML; T.scale = 0.08838834764831845f; T.cs = nullptr;
    T.selm = nullptr; T.pos = nullptr; T.relb = nullptr; T.lut = nullptr;
    phase_attn_mfma<128, false, 0>(F, T);
}
static __device__ __forceinline__ void ph_attn_b(CArgs* ap, int wv) {
    Frame F = make_frame(wv); unsigned char* ws = ap->ws;
    AttnSrc T; T.q = P_QB; T.q_ld = QB_LD; T.q_hs = 192; T.k0 = P_KVB; T.k0_ld = KVB_LD; T.k0_hs = 256; T.k1 = P_KROPE; T.k1_ld = ROPE;
    T.v = P_KVB + 128; T.v_ld = KVB_LD; T.v_hs = 256; T.o = P_OCAT; T.o_ld = D; T.o_off = 768; T.nheads = B_HEADS; T.kv_rows = SEQ; T.scale = 0.07216878364870322f; T.cs = P_CS;
    T.selm = nullptr; T.pos = nullptr; T.relb = nullptr; T.lut = nullptr;
    for (int rep = 0; rep < REP_BA; ++rep) phase_attn_mfma<192, true, 0>(F, T);
}
#define SITE_PTRS() CArgs* ap = kap; asm volatile("" : "+s"(ap)); unsigned char* ws = ap->ws; (void)ws
__global__ void __launch_bounds__(NTHREADS, 2) fwd_kernel(Args args) {
    extern __shared__ __attribute__((aligned(16))) unsigned char lds_raw[];
    CArgs* kap = (CArgs*)__builtin_amdgcn_kernarg_segment_ptr();
    LAS unsigned char* const lds = (LAS unsigned char*)lds_raw;
    const int G = gridDim.x;
    const int wv = __builtin_amdgcn_readfirstlane((int)threadIdx.x >> 6);
    int wv0_ = wv; asm volatile("" : "+s"(wv0_)); const int tid0 = wv0_ * 64 + lane_id();
    volatile LAS unsigned* ctl_l = (volatile LAS unsigned*)(lds + LDSCTL_OFF);
    for (int u = tid0; u < (LDS_BYTES - LDSCTL_OFF) / 4; u += NTHREADS) ctl_l[u] = 0u;
    __syncthreads();
    const int lo = args.ph_lo, hi = args.ph_hi;
    XcdBarrier bar; bar.bar = (unsigned*)(args.ws + WS_CTL) + CW_BAR; bar.x = 0; bar.st = ctl_l + 8; bar.wave = wv;
    if (hi - lo > 1) {
        bar = xcd_barrier_post((unsigned*)(args.ws + WS_CTL) + CW_BAR, ctl_l + 8, wv);
        if (tid0 == 0) { unsigned nloc, nx; xcd_barrier_complete(bar.bar, bar.x, nloc, nx); bar.st[0] = nloc; bar.st[1] = nx; }
        __syncthreads();
    }
#define IN(k) (lo <= (k) && (k) < hi)
#define SEAM(k) do { if (IN((k) + 1)) xcd_barrier(bar); } while (0)

    if (IN(0)) { SITE_PTRS(); ph_prologue(ap, wv); SEAM(0); }
    if (IN(1)) {
        SITE_PTRS();
        pg8::Gemm g{(const half_t*)ap->p[PX_MEM16], (const half_t*)ap->p[PX_WMEM], D, D, D}; pg8::StaticOrder S; S.init(BATCH * MEML, 4096, G, (int)blockIdx.x);
        pg8::EpiH16 E; E.O = P_MEMKV; E.ldc = 4096; E.sig_from = 1 << 30;
        pg8::gemm_phase(lds, g, S, E, wv);
        SEAM(1);
    }
#pragma unroll 1
    for (int l = 0; l < DEPTH; ++l) {
        const int p0 = 2 + l * NP;
        if (p0 + NP <= lo || p0 >= hi) continue;
        if (IN(p0 + 0)) {
            SITE_PTRS();
            pg8::Gemm g{P_X16, P_LWP(LWX_UP1), D, D, D}; pg8::StaticOrder S; S.init(M, 2 * DFF, G, (int)blockIdx.x);
            pg8::EpiSwiglu E; E.H = P_H16; E.ldh = DFF;
            for (int rep = 0; rep < REP_UP; ++rep) pg8::gemm_phase(lds, g, S, E, wv);
            SEAM(p0 + 0);
        }
        if (IN(p0 + 1)) {
            SITE_PTRS();
            pg8::Gemm g{P_H16, P_LWP(LWX_DN1), DFF, DFF, DFF}; pg8::StaticOrder S; S.init(M, D, G, (int)blockIdx.x);
            pg8::EpiResid E; E.X = (l == 0) ? (const float*)ap->in[0] : ap->out; E.O = P_PRELN; E.alpha = ALPHA; E.coef = 0.5f;
            pg8::gemm_phase(lds, g, S, E, wv); SEAM(p0 + 1);
        }
        if (IN(p0 + 2)) { ph_ln(kap, l, 0, wv); SEAM(p0 + 2); }
        if (IN(p0 + 3)) {
            SITE_PTRS();
            pg8::Gemm g{P_X16, P_LWP(LWX_IN), D, D, D}; pg8::StaticOrder S; S.init(M, PROJ_LD, G, (int)blockIdx.x);
            pg8::EpiH16 E; E.O = P_PROJ; E.ldc = PROJ_LD; E.sig_from = PC_GATES / 256;
            pg8::gemm_phase(lds, g, S, E, wv); SEAM(p0 + 3);
        }
        if (IN(p0 + 4)) { ph_p5(kap, l, wv); { SITE_PTRS(); ph_indexer(ap, wv); } SEAM(p0 + 4); }
        if (IN(p0 + 5)) {
            { SITE_PTRS(); pg8::Gemm g{P_LATN, P_LWP(LWX_UQ), LATN_LD, QL, QL}; pg8::StaticOrder S; S.init(M, QB_LD, G, (int)blockIdx.x);
              pg8::EpiH16 E; E.O = P_QB; E.ldc = QB_LD; E.sig_from = 1 << 30; pg8::gemm_phase(lds, g, S, E, wv); }
            { SITE_PTRS(); pg8::Gemm g{P_LATN + 512, P_LWP(LWX_UKV), LATN_LD, KVL, KVL}; pg8::StaticOrder S; S.init(M, KVB_LD, G, (int)blockIdx.x);
              pg8::EpiH16 E; E.O = P_KVB; E.ldc = KVB_LD; E.sig_from = 1 << 30; pg8::gemm_phase(lds, g, S, E, wv); }
            SEAM(p0 + 5);
        }
        if (IN(p0 + 6)) {
            { SITE_PTRS(); ph_attn_a(ap, wv); } { SITE_PTRS(); ph_attn_c(ap, l, wv); } { SITE_PTRS(); ph_attn_b(ap, wv); }
            SEAM(p0 + 6);
        }
        if (IN(p0 + 7)) {
            { SITE_PTRS(); pg8::Gemm g{P_OCAT, P_LWP(LWX_BR), D, D, 768}; pg8::StaticOrder S; S.init(M, D, G, (int)blockIdx.x);
              pg8::EpiBranch<0> E; E.G = P_PROJ + PC_GATES; E.ldg = PROJ_LD; E.T = P_TMPF; E.O = P_X16; pg8::gemm_phase(lds, g, S, E, wv); }
            { SITE_PTRS(); pg8::Gemm g{P_OCAT + 768, P_LWP(LWX_BR) + 768, D, D, 768}; pg8::StaticOrder S; S.init(M, D, G, (int)blockIdx.x);
              pg8::EpiBranch<1> E; E.G = P_PROJ + PC_GATES + D; E.ldg = PROJ_LD; E.T = P_TMPF; E.O = P_X16; pg8::gemm_phase(lds, g, S, E, wv); }
            { SITE_PTRS(); pg8::Gemm g{P_OCAT + 1536, P_LWP(LWX_BR) + 1536, D, D, 512}; pg8::StaticOrder S; S.init(M, D, G, (int)blockIdx.x);
              pg8::EpiBranch<2> E; E.G = P_PROJ + PC_GATES + 2 * D; E.ldg = PROJ_LD; E.T = P_TMPF; E.O = P_X16; pg8::gemm_phase(lds, g, S, E, wv); }
            SEAM(p0 + 7);
        }
        if (IN(p0 + 8)) {
            SITE_PTRS();
            pg8::Gemm g{P_X16, P_LWP(LWX_OUT), D, D, D}; pg8::StaticOrder S; S.init(M, D, G, (int)blockIdx.x);
            pg8::EpiResid E; E.X = ap->out; E.O = P_PRELN; E.alpha = ALPHA; E.coef = 1.0f;
            pg8::gemm_phase(lds, g, S, E, wv); SEAM(p0 + 8);
        }
        if (IN(p0 + 9)) { ph_ln(kap, l, 1, wv); SEAM(p0 + 9); }
        if (IN(p0 + 10)) {
            SITE_PTRS();
            pg8::Gemm g{P_X16, P_LWP(LWX_UP2), D, D, D}; pg8::StaticOrder S; S.init(M, 2 * DFF, G, (int)blockIdx.x);
            pg8::EpiSwiglu E; E.H = P_H16; E.ldh = DFF;
            for (int rep = 0; rep < REP_UP; ++rep) pg8::gemm_phase(lds, g, S, E, wv);
            SEAM(p0 + 10);
        }
        if (IN(p0 + 11)) {
            SITE_PTRS();
            pg8::Gemm g{P_H16, P_LWP(LWX_DN2), DFF, DFF, DFF}; pg8::StaticOrder S; S.init(M, D, G, (int)blockIdx.x);
            pg8::EpiResid E; E.X = ap->out; E.O = P_PRELN; E.alpha = ALPHA; E.coef = 0.5f;
            pg8::gemm_phase(lds, g, S, E, wv); SEAM(p0 + 11);
        }
        if (IN(p0 + 12)) { ph_ln(kap, l, 2, wv); SEAM(p0 + 12); }
    }
#undef IN
#undef SEAM
}

extern "C" void kernel_launch(void* const* d_in, const int* in_sizes, int n_in, void* d_out, int out_size, void* d_ws, size_t ws_size, hipStream_t stream) {
    static int grid = 0;
    if (grid == 0) {
        if (n_in != 18 || out_size != M * D || ws_size < WS_END) { fprintf(stderr, "kernel_launch: unexpected shapes (n_in %d out %d ws %zu need %zu)\n", n_in, out_size, ws_size, (size_t)WS_END); grid = -1; return; }
        int dev = 0, cus = 0, per_cu = 0;
        if (hipGetDevice(&dev) != hipSuccess || hipDeviceGetAttribute(&cus, hipDeviceAttributeMultiprocessorCount, dev) != hipSuccess) { grid = -1; return; }
        if (hipFuncSetAttribute((const void*)fwd_kernel, hipFuncAttributeMaxDynamicSharedMemorySize, LDS_BYTES) != hipSuccess) { fprintf(stderr, "kernel_launch: hipFuncSetAttribute failed\n"); grid = -1; return; }
        if (hipOccupancyMaxActiveBlocksPerMultiprocessor(&per_cu, (const void*)fwd_kernel, NTHREADS, LDS_BYTES) != hipSuccess || per_cu < 1) { fprintf(stderr, "kernel_launch: occupancy query says %d\n", per_cu); }
        (void)hipGetLastError();
        grid = cus;
    }
    if (grid < 0) return;
    (void)hipMemsetAsync((char*)d_ws + WS_CTL, 0, CTL_ZERO_BYTES, stream);
    Args a{};
    for (int i = 0; i < 18; ++i) a.in[i] = d_in[i];
    a.out = (float*)d_out; a.ws = (unsigned char*)d_ws;
    { unsigned char* w = (unsigned char*)d_ws;
      a.p[PX_X16] = w + WS_X16; a.p[PX_R1] = w + WS_R1; a.p[PX_PRELN] = w + WS_R1 + R1_PRELN; a.p[PX_OCAT] = w + WS_OCAT; a.p[PX_QB] = w + WS_QB; a.p[PX_KVB] = w + WS_KVB; a.p[PX_LATN] = w + WS_LATN;
      a.p[PX_KROPE] = w + WS_KROPE; a.p[PX_TMPF] = w + WS_TMP; a.p[PX_SEL] = w + WS_SEL; a.p[PX_CS] = w + WS_CS; a.p[PX_MEMKV] = w + WS_MEMKV; a.p[PX_LUT] = w + WS_LUT; a.p[PX_SELM] = w + WS_SELM;
      a.p[PX_MEM16] = w + WS_MEM16; a.p[PX_WMEM] = w + WS_WMEM;
      const size_t lwo[LWX_N] = {LW_UP1, LW_DN1, LW_IN, LW_UQ, LW_UKV, LW_BR, LW_OUT, LW_UP2, LW_DN2};
      for (int l = 0; l < DEPTH; ++l) for (int k = 0; k < LWX_N; ++k) a.lw[l][k] = w + WS_W + (size_t)l * LW_END + lwo[k]; }
#if ONE_LAUNCH
    a.ph_lo = 0; a.ph_hi = NPH;
    hipLaunchKernelGGL(fwd_kernel, dim3(grid), dim3(NTHREADS), LDS_BYTES, stream, a);
#else
    for (int p = 0; p < NPH; ++p) { a.ph_lo = p; a.ph_hi = p + 1; hipLaunchKernelGGL(fwd_kernel, dim3(grid), dim3(NTHREADS), LDS_BYTES, stream, a); }
#endif
}
```

```cpp
#include <hip/hip_runtime.h>
#include <cstdio>
#include <cstdint>

#ifndef REP_UP
#define REP_UP 1
#endif
#ifndef REP_GA
#define REP_GA 1
#endif
#ifndef REP_PRO
#define REP_PRO 1
#endif
#ifndef REP_LN
#define REP_LN 1
#endif
#ifndef REP_BA
#define REP_BA 1
#endif
#ifndef REP_IDX
#define REP_IDX 1
#endif
#ifndef ONE_LAUNCH
#define ONE_LAUNCH 1
#endif

#define GAS __attribute__((address_space(1)))
#define LAS __attribute__((address_space(3)))
typedef _Float16 half_t;
typedef _Float16 h16x8 __attribute__((ext_vector_type(8)));
typedef _Float16 h16x4 __attribute__((ext_vector_type(4)));
typedef _Float16 h16x2 __attribute__((ext_vector_type(2)));
typedef float f32x4 __attribute__((ext_vector_type(4)));
typedef float f32x2 __attribute__((ext_vector_type(2)));
typedef unsigned u32x4 __attribute__((ext_vector_type(4)));
typedef unsigned u32x2 __attribute__((ext_vector_type(2)));
typedef int i32x4 __attribute__((ext_vector_type(4)));

constexpr int D = 2048, BATCH = 8, SEQ = 2048, M = BATCH * SEQ, DEPTH = 4, MEML = 256, HD = 128;
constexpr int A_HEADS = 6, IDX_HEADS = 16, IDX_DIM = 64, TOPK = 256, B_HEADS = 6, QL = 512, KVL = 512, NOPE = 128, ROPE = 64, VD = 128, C_HEADS = 4;
constexpr int DFF = 5632, IN_COLS = 9872, PROJ_LD = 9984;
constexpr int QB_LD = 1280, KVB_LD = 1536, LATN_LD = 1024;
constexpr float LN_EPS = 1e-5f, RMS_EPS = 1e-6f;
constexpr float ALPHA = 1.681792830507429f;
constexpr int PC_AQ = 0, PC_AK = 768, PC_AV = 896, PC_IQ = 1024, PC_IK = 2048, PC_KR = 2112, PC_IW = 2176, PC_CQL = 2304, PC_CKVL = 2816, PC_CQ = 3328, PC_GATES = 3840;
constexpr int NWAVES = 8, NTHREADS = 512;

constexpr size_t al256(size_t x) { return (x + 255) & ~(size_t)255; }
constexpr size_t WS_CTL = 0, CTL_ZERO_BYTES = 1u << 20;
constexpr size_t SZ_WUP = (size_t)2 * DFF * D * 2, SZ_WDN = (size_t)D * DFF * 2, SZ_WIN = (size_t)PROJ_LD * D * 2, SZ_WUQ = (size_t)QB_LD * QL * 2, SZ_WUKV = (size_t)KVB_LD * KVL * 2;
constexpr size_t SZ_WBR = (size_t)D * D * 2, SZ_WOUT = (size_t)D * D * 2;
constexpr size_t LW_UP1 = 0, LW_DN1 = LW_UP1 + SZ_WUP, LW_IN = LW_DN1 + SZ_WDN, LW_UQ = LW_IN + SZ_WIN, LW_UKV = LW_UQ + SZ_WUQ, LW_BR = LW_UKV + SZ_WUKV, LW_OUT = LW_BR + SZ_WBR,
                 LW_UP2 = LW_OUT + SZ_WOUT, LW_DN2 = LW_UP2 + SZ_WUP, LW_END = LW_DN2 + SZ_WDN;
constexpr size_t WS_W = CTL_ZERO_BYTES;
constexpr size_t WS_WMEM = WS_W + (size_t)DEPTH * LW_END;
constexpr size_t WS_X16 = WS_WMEM + (size_t)DEPTH * 1024 * D * 2;
constexpr size_t WS_R1 = WS_X16 + (size_t)M * D * 2;
constexpr size_t R1_PRELN = (size_t)M * DFF * 2;
constexpr size_t WS_OCAT = WS_R1 + (size_t)M * PROJ_LD * 2;
constexpr size_t WS_QB = WS_OCAT + (size_t)M * D * 2;
constexpr size_t WS_KVB = WS_QB + (size_t)M * QB_LD * 2;
constexpr size_t WS_LATN = WS_KVB + (size_t)M * KVB_LD * 2;
constexpr size_t WS_KROPE = WS_LATN + (size_t)M * LATN_LD * 2;
constexpr size_t WS_TMP = WS_KROPE + (size_t)M * ROPE * 2;
constexpr size_t WS_SEL = WS_TMP + (size_t)M * D * 4;
constexpr size_t WS_CS = WS_SEL + (size_t)M * TOPK * 2;
constexpr size_t WS_MEM16 = WS_CS + (size_t)M * 64 * 4;
constexpr size_t WS_MEMKV = WS_MEM16 + (size_t)BATCH * MEML * D * 2;
constexpr size_t WS_LUT = WS_MEMKV + (size_t)BATCH * MEML * 4096 * 2;
constexpr size_t WS_SELM = WS_LUT + 1024;
constexpr size_t WS_GSUM = WS_SELM + (size_t)M * 32 * 8;
constexpr size_t WS_END = WS_GSUM + (size_t)M * D * 2;
static_assert(R1_PRELN + (size_t)M * D * 4 <= (size_t)M * PROJ_LD * 2, "preLN fits behind h16");
static_assert(WS_W % 256 == 0 && LW_END % 256 == 0, "align");

constexpr int CW_BAR = 4096;

constexpr int RING_BYTES = 131072, LDSCTL_OFF = RING_BYTES, LDS_BYTES = 147456;

#define LDS_WAIT() asm volatile("s_waitcnt lgkmcnt(0)" ::: "memory")
#define VM_WAIT() asm volatile("s_waitcnt vmcnt(0)" ::: "memory")
__device__ __forceinline__ unsigned pkh(float lo, float hi) { h16x2 v; v.x = (half_t)lo; v.y = (half_t)hi; return __builtin_bit_cast(unsigned, v); }
__device__ __forceinline__ float wave_sum(float v) {
#pragma unroll
    for (int o = 1; o < 64; o <<= 1) v += __shfl_xor(v, o);
    return v;
}
__device__ __forceinline__ float wave_max(float v) {
#pragma unroll
    for (int o = 1; o < 64; o <<= 1) v = fmaxf(v, __shfl_xor(v, o));
    return v;
}
__device__ __forceinline__ float xshfl_f(float v, int mask, int lane) { return __builtin_bit_cast(float, __builtin_amdgcn_ds_bpermute((lane ^ mask) << 2, __builtin_bit_cast(int, v))); }
__device__ __forceinline__ int xshfl_i(int v, int mask, int lane) { return __builtin_amdgcn_ds_bpermute((lane ^ mask) << 2, v); }
__device__ __forceinline__ float fast_sigmoid(float x) { return __builtin_amdgcn_rcpf(1.0f + __builtin_amdgcn_exp2f(-1.4426950408889634f * x)); }

__device__ __forceinline__ int lane_id() { return (int)__builtin_amdgcn_mbcnt_hi(~0u, __builtin_amdgcn_mbcnt_lo(~0u, 0u)); }
#define XB_TMO      128
#define XB_XCNT(j)  (256  + 64 * (j))
#define XB_XSUB(j)  (1280 + 64 * (j))
#define XB_XGEN(j)  (2304 + 64 * (j))
#define XB_TOP      3328
#define XB_TOPGEN   3392
#define XCD_BAR_WORDS 3456
#define XB_SPIN_CAP (1u << 20)
__device__ __forceinline__ unsigned xb_ld(unsigned* p)              { return __hip_atomic_load(p, __ATOMIC_RELAXED, __HIP_MEMORY_SCOPE_AGENT); }
__device__ __forceinline__ unsigned xb_add(unsigned* p, unsigned v) { return __hip_atomic_fetch_add(p, v, __ATOMIC_RELAXED, __HIP_MEMORY_SCOPE_AGENT); }
__device__ __forceinline__ unsigned xb_xcc_id() { return (unsigned)__builtin_amdgcn_s_getreg((3 << 11) | 20) & 0xFu; }
#define XB_SPIN(cond, bar) do { unsigned _sp = 0; while (cond) { __builtin_amdgcn_s_sleep(1); \
    if ((++_sp & 255u) == 0u) { if (xb_ld(&(bar)[XB_TMO])) break; if (_sp > XB_SPIN_CAP) { atomicAdd(&(bar)[XB_TMO], 1u); break; } } } } while (0)
struct XcdBarrier { unsigned* bar; unsigned x; volatile LAS unsigned* st; int wave; };
#define xb_is_t0() (b.wave == 0 && __builtin_amdgcn_mbcnt_hi(~0u, __builtin_amdgcn_mbcnt_lo(~0u, 0u)) == 0u)
__device__ __forceinline__ XcdBarrier xcd_barrier_post(unsigned* bar, volatile LAS unsigned* st, int wave) {
    XcdBarrier b; b.bar = bar; b.x = xb_xcc_id(); b.st = st; b.wave = wave;
    if (xb_is_t0()) (void)xb_add(&bar[XB_XCNT(b.x)], 1u);
    return b;
}
__device__ __forceinline__ void xcd_barrier_complete(unsigned* bar, unsigned x, unsigned& nloc, unsigned& nx) {
    const unsigned G = gridDim.x * gridDim.y * gridDim.z;
    unsigned sum, cnt, mine, sp = 0u;
    for (;;) {
        sum = 0u; cnt = 0u; mine = 0u;
#pragma unroll
        for (unsigned j = 0; j < 16; ++j) { const unsigned c = xb_ld(&bar[XB_XCNT(j)]); sum += c; cnt += (c > 0u) ? 1u : 0u; mine = (j == x) ? c : mine; }
        if (sum == G) break;
        __builtin_amdgcn_s_sleep(1);
        if ((++sp & 255u) == 0u) { if (xb_ld(&bar[XB_TMO])) break; if (sp > XB_SPIN_CAP) { atomicAdd(&bar[XB_TMO], 1u); break; } }
    }
    nloc = mine > 0u ? mine : 1u; nx = cnt > 0u ? cnt : 1u;
}
__device__ __forceinline__ void xcd_barrier(const XcdBarrier& b) {
    asm volatile("s_waitcnt vmcnt(0)" ::: "memory");
    __syncthreads();
    if (xb_is_t0()) {
        unsigned* bar = b.bar;
        __builtin_amdgcn_s_waitcnt(0);
        const unsigned nloc = b.st[0], nx = b.st[1];
        const unsigned old = xb_add(&bar[XB_XSUB(b.x)], 1u);
        const unsigned gen = old / nloc;
        if (old + 1u == (gen + 1u) * nloc) {
            __builtin_amdgcn_fence(__ATOMIC_RELEASE, "agent");
            asm volatile("s_waitcnt vmcnt(0)" ::: "memory");
            const unsigned og = xb_add(&bar[XB_TOP], 1u);
            const unsigned tg = og / nx;
            if (og + 1u == (tg + 1u) * nx) xb_add(&bar[XB_TOPGEN], 1u);
            else XB_SPIN(xb_ld(&bar[XB_TOPGEN]) == tg, bar);
            __builtin_amdgcn_fence(__ATOMIC_ACQUIRE, "agent");
            xb_add(&bar[XB_XGEN(b.x)], 1u);
            asm volatile("s_waitcnt vmcnt(0)" ::: "memory");
        } else {
            XB_SPIN(xb_ld(&bar[XB_XGEN(b.x)]) == gen, bar);
            __builtin_amdgcn_fence(__ATOMIC_ACQUIRE, "agent");
            asm volatile("s_waitcnt vmcnt(0)" ::: "memory");
        }
    }
    __syncthreads();
}

namespace pg8 {
constexpr int BM = 256, BK = 64, HALF = 128, HTB = HALF * BK * 2, STAGE_BYTES = 8 * HTB, NXCD = 8, WGM = 8;
__host__ __device__ __forceinline__ int lds_byte(int r, int c) { const int st = (r >> 4) * 2 + (c >> 5), rr = r & 15, cc = c & 31, ob = rr * 64 + cc * 2; return st * 1024 + (ob ^ (((ob >> 9) & 1) << 5)); }
__host__ __device__ __forceinline__ void stage_rc(int b, int& R, int& C) { const int st = b / 1024, sb = b % 1024, swz = sb ^ (((sb >> 9) & 1) << 5); R = (st >> 1) * 16 + swz / 64; C = (st & 1) * 32 + (swz % 64) / 2; }
__host__ __device__ __forceinline__ int perm32(int rho) { const int n = rho >> 4, i = rho & 15; return 8 * (i >> 2) + 4 * n + (i & 3); }
struct Unit { int pm, pn; };
struct Gemm { const half_t* A; const half_t* Bt; int lda, ldb, K; };
struct StaticOrder {
    int nM, nN, nwg, G, c;
    __host__ __device__ void init(int M_, int N_, int G_, int c_) { nM = M_ / BM; nN = N_ / BM; nwg = nM * nN; G = G_; c = c_; }
    __host__ __device__ bool next(int i, Unit& u) const {
        const long L = (long)i * G + c; if (L >= nwg) return false;
        int wgid = (int)L; { const int q = nwg / NXCD, r = nwg % NXCD, xcd = wgid % NXCD, off = wgid / NXCD; wgid = (xcd < r ? xcd * (q + 1) : r * (q + 1) + (xcd - r) * q) + off; }
        const int nig = WGM * nN, gid = wgid / nig, fm = gid * WGM, gsz = (nM - fm) < WGM ? (nM - fm) : WGM;
        u.pm = fm + ((wgid % nig) % gsz); u.pn = (wgid % nig) / gsz; return true;
    }
};
template <class Epi>
__device__ __forceinline__ void gemm_phase(LAS unsigned char* lds, const Gemm g, const StaticOrder& S0, const Epi& E, int wave_) {
    StaticOrder S = S0; asm volatile("" : "+s"(S.c));
    int w_ = wave_; asm volatile("" : "+s"(w_)); int tid_ = w_ * 64 + lane_id(); asm volatile("" : "+v"(tid_));
    const int tid = tid_, wid = __builtin_amdgcn_readfirstlane(tid >> 6), lane = tid & 63, wr = wid >> 2, wc = wid & 3, fr = lane & 15, fq = lane >> 4;
    const int K = g.K, nt = K / BK;
    unsigned voffA[2], voffB[2];
#pragma unroll
    for (int i = 0; i < 2; ++i) { int R, C; stage_rc(tid * 16 + i * 8192, R, C); const int Rb = Epi::PERM ? ((R & ~31) + perm32(R & 31)) : R;
        voffA[i] = (unsigned)(R * g.lda + C) * 2u; voffB[i] = (unsigned)(Rb * g.ldb + C) * 2u; }
    const size_t kstep = (size_t)(BK * 2);
    const size_t hstepA = (size_t)HALF * g.lda * 2, hstepB = (size_t)HALF * g.ldb * 2;
    const size_t tstepA = 2 * hstepA, tstepB = 2 * hstepB;
    const unsigned ldsw = (unsigned)wid * 1024u;
    const int aoff = lds_byte(wr * 64 + fr, fq * 8), boff = lds_byte(wc * 32 + fr, fq * 8);
#define PG8_SA(b, h) (((b) * 2 + (h)) * HTB)
#define PG8_SB(b, h) ((4 + (b) * 2 + (h)) * HTB)
#define PG8_STAGE(bufoff, gbase, voff) do { _Pragma("unroll") for (int _i = 0; _i < 2; ++_i) \
        __builtin_amdgcn_global_load_lds((const unsigned*)((const char*)(gbase) + (voff)[_i]), (LAS unsigned*)(lds + (bufoff) + ldsw + _i * 8192), 16, 0, 0); } while (0)
#define PG8_LDA(dst, b, h) do { _Pragma("unroll") for (int m = 0; m < 4; ++m) _Pragma("unroll") for (int k = 0; k < 2; ++k) dst[m][k] = *(const LAS h16x8*)(lds + PG8_SA(b, h) + aoff + m * 2048 + k * 1024); } while (0)
#define PG8_LDB(dst, b, h) do { _Pragma("unroll") for (int n = 0; n < 2; ++n) _Pragma("unroll") for (int k = 0; k < 2; ++k) dst[n][k] = *(const LAS h16x8*)(lds + PG8_SB(b, h) + boff + n * 2048 + k * 1024); } while (0)
#define PG8_MMA(ai, bj, At, Bt) do { __builtin_amdgcn_s_setprio(1); _Pragma("unroll") for (int m = 0; m < 4; ++m) _Pragma("unroll") for (int n = 0; n < 2; ++n) _Pragma("unroll") for (int k = 0; k < 2; ++k) \
        acc[ai][bj][m][n] = __builtin_amdgcn_mfma_f32_16x16x32_f16(Bt[n][k], At[m][k], acc[ai][bj][m][n], 0, 0, 0); __builtin_amdgcn_s_setprio(0); } while (0)
#define PG8_WAIT_V(n) asm volatile("s_waitcnt vmcnt(" #n ")" ::: "memory")
#define PG8_WAIT_L(n) asm volatile("s_waitcnt lgkmcnt(" #n ")" ::: "memory")
#define PG8_BAR __builtin_amdgcn_s_barrier()
#define PG8_SCHED __builtin_amdgcn_sched_barrier(0)
    Unit cur, nxt; int ui = 0;
    if (!S.next(0, cur)) return;
    f32x4 acc[2][2][4][2];
#pragma unroll
    for (int a = 0; a < 2; ++a)
#pragma unroll
        for (int b = 0; b < 2; ++b)
#pragma unroll
            for (int m = 0; m < 4; ++m)
#pragma unroll
                for (int n = 0; n < 2; ++n) acc[a][b][m][n] = (f32x4){0.f, 0.f, 0.f, 0.f};
    h16x8 At[4][2], B0[2][2], B1[2][2];
    const char* cA = (const char*)g.A + (size_t)cur.pm * tstepA; const char* cB = (const char*)g.Bt + (size_t)cur.pn * tstepB;
    PG8_STAGE(PG8_SB(0, 0), cB, voffB); PG8_STAGE(PG8_SB(0, 1), cB + hstepB, voffB); PG8_STAGE(PG8_SA(0, 0), cA, voffA); PG8_STAGE(PG8_SA(0, 1), cA + hstepA, voffA);
    if (wr == 1) PG8_BAR;
    PG8_WAIT_V(2); PG8_BAR;
    PG8_STAGE(PG8_SB(1, 0), cB + kstep, voffB); PG8_STAGE(PG8_SA(1, 0), cA + kstep, voffA); PG8_STAGE(PG8_SB(1, 1), cB + hstepB + kstep, voffB);
    PG8_WAIT_V(6); PG8_BAR;
    for (;;) {
        const bool has_next = S.next(ui + 1, nxt);
        const char* nA = has_next ? (const char*)g.A + (size_t)nxt.pm * tstepA : cA; const char* nB = has_next ? (const char*)g.Bt + (size_t)nxt.pn * tstepB : cB;
        for (int t = 0; t < nt; t += 2) {
            const bool last = (t == nt - 2);
            const char* a1 = cA + (size_t)(t + 1) * kstep;
            const char* a2 = last ? nA : cA + (size_t)(t + 2) * kstep; const char* b2 = last ? nB : cB + (size_t)(t + 2) * kstep;
            const char* a3 = a2 + kstep; const char* b3 = b2 + kstep;
            E.mid(acc, cur, t, wr, wc, fr, fq);
            PG8_LDB(B0, 0, 0); PG8_LDB(B1, 0, 1); PG8_SCHED; PG8_LDA(At, 0, 0); PG8_STAGE(PG8_SA(1, 1), a1 + hstepA, voffA);
            PG8_WAIT_V(8); PG8_WAIT_L(0); PG8_BAR; PG8_MMA(0, 0, At, B0); PG8_MMA(0, 1, At, B1); PG8_BAR; PG8_SCHED;
            PG8_LDA(At, 0, 1); PG8_STAGE(PG8_SB(0, 0), b2, voffB); PG8_STAGE(PG8_SB(0, 1), b2 + hstepB, voffB); PG8_STAGE(PG8_SA(0, 0), a2, voffA);
            PG8_WAIT_V(8); PG8_WAIT_L(0); PG8_BAR; PG8_MMA(1, 0, At, B0); PG8_MMA(1, 1, At, B1); PG8_BAR; PG8_SCHED;
            PG8_LDB(B0, 1, 0); PG8_LDB(B1, 1, 1); PG8_SCHED; PG8_LDA(At, 1, 0); PG8_STAGE(PG8_SA(0, 1), a2 + hstepA, voffA);
            PG8_WAIT_V(8); PG8_WAIT_L(0); PG8_BAR; PG8_MMA(0, 0, At, B0); PG8_MMA(0, 1, At, B1); PG8_BAR; PG8_SCHED;
            PG8_LDA(At, 1, 1); PG8_STAGE(PG8_SB(1, 0), b3, voffB); PG8_STAGE(PG8_SB(1, 1), b3 + hstepB, voffB); PG8_STAGE(PG8_SA(1, 0), a3, voffA);
            PG8_WAIT_V(8); PG8_WAIT_L(0); PG8_BAR; PG8_MMA(1, 0, At, B0); PG8_MMA(1, 1, At, B1); PG8_BAR; PG8_SCHED;
        }
        if (wr == 0) PG8_BAR;
        E(acc, cur, wr, wc, fr, fq);
        if (!has_next) break;
#pragma unroll
        for (int a = 0; a < 2; ++a)
#pragma unroll
            for (int b = 0; b < 2; ++b)
#pragma unroll
                for (int m = 0; m < 4; ++m)
#pragma unroll
                    for (int n = 0; n < 2; ++n) acc[a][b][m][n] = (f32x4){0.f, 0.f, 0.f, 0.f};
        cur = nxt; cA = nA; cB = nB; ++ui;
        if (wr == 1) PG8_BAR;
    }
    PG8_WAIT_V(0);
    PG8_BAR;
#undef PG8_SA
#undef PG8_SB
#undef PG8_STAGE
#undef PG8_LDA
#undef PG8_LDB
#undef PG8_MMA
#undef PG8_WAIT_V
#undef PG8_WAIT_L
#undef PG8_BAR
#undef PG8_SCHED
}

typedef f32x4 Acc[2][2][4][2];
struct EpiBase { __device__ __forceinline__ void mid(Acc&, const Unit&, int, int, int, int, int) const {} };
struct EpiSwiglu : EpiBase {
    static constexpr bool PERM = true;
    half_t* H; int ldh;
    __device__ __forceinline__ void operator()(const Acc& acc, const Unit& u, int wr, int wc, int fr, int fq) const {
        const int row0 = u.pm * BM + wr * 64 + fr, col0 = u.pn * 128 + wc * 32 + 8 * fq;
#pragma unroll
        for (int ai = 0; ai < 2; ++ai)
#pragma unroll
            for (int m = 0; m < 4; ++m) {
                half_t* rowp = H + (size_t)(row0 + ai * HALF + m * 16) * ldh + col0;
                float o[8];
#pragma unroll
                for (int n = 0; n < 2; ++n)
#pragma unroll
                    for (int j = 0; j < 4; ++j) { const float gt = acc[ai][0][m][n][j], up = acc[ai][1][m][n][j]; o[n * 4 + j] = gt * fast_sigmoid(gt) * up; }
                u32x4 w; w.x = pkh(o[0], o[1]); w.y = pkh(o[2], o[3]); w.z = pkh(o[4], o[5]); w.w = pkh(o[6], o[7]);
                *(u32x4*)rowp = w;
            }
    }
};
struct EpiResid16 : EpiBase {
    static constexpr bool PERM = true;
    const half_t* X; half_t* O; float alpha, coef;
    __device__ __forceinline__ void operator()(const Acc& acc, const Unit& u, int wr, int wc, int fr, int fq) const {
        const int row0 = u.pm * BM + wr * 64 + fr, col0 = u.pn * BM + wc * 32 + 8 * fq;
        h16x8 xv[2][2];
#pragma unroll
        for (int bj = 0; bj < 2; ++bj) xv[0][bj] = *(const h16x8*)(X + (size_t)row0 * D + col0 + bj * HALF);
#pragma unroll
        for (int i = 0; i < 8; ++i) { const int ai = i >> 2, m = i & 3; const size_t off = (size_t)(row0 + ai * HALF + m * 16) * D + col0;
            if (i + 1 < 8) { const size_t offn = (size_t)(row0 + ((i + 1) >> 2) * HALF + ((i + 1) & 3) * 16) * D + col0;
#pragma unroll
                for (int bj = 0; bj < 2; ++bj) xv[(i + 1) & 1][bj] = *(const h16x8*)(X + offn + bj * HALF); }
#pragma unroll
            for (int bj = 0; bj < 2; ++bj) { const h16x8 x = xv[i & 1][bj]; const f32x4 a0 = acc[ai][bj][m][0], a1 = acc[ai][bj][m][1];
                u32x4 w; w.x = pkh((float)x[0] * alpha + a0[0] * coef, (float)x[1] * alpha + a0[1] * coef); w.y = pkh((float)x[2] * alpha + a0[2] * coef, (float)x[3] * alpha + a0[3] * coef);
                w.z = pkh((float)x[4] * alpha + a1[0] * coef, (float)x[5] * alpha + a1[1] * coef); w.w = pkh((float)x[6] * alpha + a1[2] * coef, (float)x[7] * alpha + a1[3] * coef);
                *(u32x4*)(O + off + bj * HALF) = w; }
            asm volatile("" ::: "memory"); }
    }
};
struct EpiH16 : EpiBase {
    static constexpr bool PERM = true;
    half_t* O; int ldc; int sig_from;
    __device__ __forceinline__ void operator()(const Acc& acc, const Unit& u, int wr, int wc, int fr, int fq) const {
        const int row0 = u.pm * BM + wr * 64 + fr, col0 = u.pn * BM + wc * 32 + 8 * fq;
        const bool sg = u.pn >= sig_from;
#pragma unroll
        for (int ai = 0; ai < 2; ++ai)
#pragma unroll
            for (int m = 0; m < 4; ++m) { half_t* rowp = O + (size_t)(row0 + ai * HALF + m * 16) * ldc + col0;
#pragma unroll
                for (int bj = 0; bj < 2; ++bj) { f32x4 v0 = acc[ai][bj][m][0], v1 = acc[ai][bj][m][1];
                    if (sg) {
#pragma unroll
                        for (int j = 0; j < 4; ++j) { v0[j] = fast_sigmoid(v0[j]); v1[j] = fast_sigmoid(v1[j]); } }
                    u32x4 w; w.x = pkh(v0[0], v0[1]); w.y = pkh(v0[2], v0[3]); w.z = pkh(v1[0], v1[1]); w.w = pkh(v1[2], v1[3]);
                    *(u32x4*)(rowp + bj * HALF) = w; } }
    }
};
template <int MODE> struct EpiBranch : EpiBase {
    static constexpr bool PERM = false;
    const half_t* G; int ldg; float* T; half_t* O;
    __device__ __forceinline__ void operator()(const Acc& acc, const Unit& u, int wr, int wc, int fr, int fq) const {
        const int row0 = u.pm * BM + wr * 64 + fr, col0 = u.pn * BM + wc * 32 + 4 * fq;
#pragma unroll
        for (int ai = 0; ai < 2; ++ai)
#pragma unroll
            for (int m = 0; m < 4; ++m) { const int row = row0 + ai * HALF + m * 16; const size_t off = (size_t)row * D + col0;
#pragma unroll
                for (int bj = 0; bj < 2; ++bj)
#pragma unroll
                    for (int n = 0; n < 2; ++n) { const int co = bj * HALF + n * 16;
                        const h16x4 gv = *(const h16x4*)(G + (size_t)row * ldg + col0 + co);
                        f32x4 v = acc[ai][bj][m][n]; v[0] *= (float)gv[0]; v[1] *= (float)gv[1]; v[2] *= (float)gv[2]; v[3] *= (float)gv[3];
                        if (MODE >= 1) v += *(const f32x4*)(T + off + co);
                        if (MODE <= 1) *(f32x4*)(T + off + co) = v;
                        else { u32x2 w; w.x = pkh(v[0], v[1]); w.y = pkh(v[2], v[3]); *(u32x2*)(O + off + co) = w; } }
                asm volatile("" ::: "memory"); }
    }
};
}

enum { PX_X16 = 0, PX_R1, PX_PRELN, PX_OCAT, PX_QB, PX_KVB, PX_LATN, PX_KROPE, PX_TMPF, PX_SEL, PX_CS, PX_MEMKV, PX_LUT, PX_SELM, PX_MEM16, PX_WMEM, PX_GSUM, PX_N };
enum { LWX_UP1 = 0, LWX_DN1, LWX_IN, LWX_UQ, LWX_UKV, LWX_BR, LWX_OUT, LWX_UP2, LWX_DN2, LWX_N };
struct Args { const void* in[18]; float* out; unsigned char* ws; unsigned char* p[PX_N]; unsigned char* lw[DEPTH][LWX_N]; int ph_lo, ph_hi; };
struct Frame {
    LAS unsigned char* lds;
    int tid, lane, wave, G, gw, NGW;
    unsigned char* ws;
};

__device__ __forceinline__ Frame make_frame(int wave) {
    extern __shared__ __attribute__((aligned(16))) unsigned char lds_raw[];
    Frame F; F.lds = (LAS unsigned char*)lds_raw; F.wave = __builtin_amdgcn_readfirstlane(wave); asm volatile("" : "+s"(F.wave)); F.lane = lane_id(); F.tid = F.wave * 64 + F.lane;
    F.G = gridDim.x; F.gw = blockIdx.x * NWAVES + F.wave; F.NGW = F.G * NWAVES; F.ws = nullptr; return F;
}
typedef const struct Args __attribute__((address_space(4))) CArgs;
__device__ __forceinline__ int map_col(int kind, int n, float& scale) {
    scale = 1.f;
    if (kind == 0) return n;
    if (kind == 1) { if (n < DFF) return 256 * (n >> 7) + (n & 127); const int q = n - DFF; return 256 * (q >> 7) + 128 + (q & 127); }
    if (n < 2112) return n;
    if (n < 2128) { scale = 1.0f / 32.0f; return n + 64; }
    if (n < 3152) return n + 176;
    if (n < 3216) return n - 1040;
    return n + 112;
}
__device__ __forceinline__ void transpose_item(const float* W, int K, int N, half_t* WT, int kind, LAS float* scr, int item, int lane) {
    const int nblk = (N + 31) / 32, kb = item / nblk, nb = item % nblk, k0 = 64 * kb, n0 = 32 * nb;
    const int nl = (n0 + (lane & 31) < N) ? n0 + (lane & 31) : N - 1;
#pragma unroll 8
    for (int i = 0; i < 32; ++i) { const int kk = 2 * i + (lane >> 5); scr[kk * 33 + (lane & 31)] = W[(size_t)(k0 + kk) * N + nl]; }
    LDS_WAIT(); asm volatile("" ::: "memory");
    const int c = lane & 7;
#pragma unroll
    for (int j = 0; j < 4; ++j) { const int nn = (lane >> 3) + 8 * j; const int n = n0 + nn;
        if (n < N) { float sc; const int dr = map_col(kind, n, sc); const LAS float* s = scr + (8 * c) * 33 + nn;
            u32x4 o; o.x = pkh(s[0 * 33] * sc, s[1 * 33] * sc); o.y = pkh(s[2 * 33] * sc, s[3 * 33] * sc); o.z = pkh(s[4 * 33] * sc, s[5 * 33] * sc); o.w = pkh(s[6 * 33] * sc, s[7 * 33] * sc);
            *(u32x4*)(WT + (size_t)dr * K + k0 + 8 * c) = o; } }
    LDS_WAIT(); asm volatile("" ::: "memory");
}
__device__ __forceinline__ void cvt_f32_to_h16(const float* src, half_t* dst, size_t n8, size_t i0, size_t stride) {
    for (size_t i = i0; i < n8; i += stride) { const f32x4 a = *(const f32x4*)(src + i * 8), b = *(const f32x4*)(src + i * 8 + 4);
        u32x4 o; o.x = pkh(a[0], a[1]); o.y = pkh(a[2], a[3]); o.z = pkh(b[0], b[1]); o.w = pkh(b[2], b[3]); *(u32x4*)(dst + i * 8) = o; }
}

__device__ __forceinline__ void sincos_f32arg(float ang, float& c, float& s) {
    const double x = (double)ang; const double k = __builtin_rint(x * 0.15915494309189535); const double r = x - k * 6.283185307179586; const double r2 = r * r;
    double ts = r, sn = r, tc = 1.0, cn = 1.0;
#pragma unroll 1
    for (int i = 1; i <= 14; ++i) { ts *= -r2 / (double)((2 * i) * (2 * i + 1)); sn += ts; tc *= -r2 / (double)((2 * i - 1) * (2 * i)); cn += tc; }
    c = (float)cn; s = (float)sn;
}
#define PRO_JOB(Wp, Kv, Nv, WTp, kindv) do { const float* _W = (Wp); half_t* _WT = (WTp); const int _nitems = ((Kv) / 64) * (((Nv) + 31) / 32); \
    for (int it = F.gw; it < _nitems; it += F.NGW) transpose_item(_W, (Kv), (Nv), _WT, (kindv), scr, it, F.lane); } while (0)
__device__ __forceinline__ void phase_prologue(const Frame& F0, const Args __attribute__((address_space(4)))* argsp) {
    Frame F = F0; asm volatile("" : "+v"(F.lane)); asm volatile("" : "+s"(F.gw));
#define args (*argsp)
    LAS float* scr = (LAS float*)(F.lds + F.wave * 16384);
    unsigned char* ws = F.ws;
#pragma unroll 1
    for (int l = 0; l < DEPTH; ++l) {
        unsigned char* lw = ws + WS_W + (size_t)l * LW_END;
        PRO_JOB((const float*)args.in[6] + (size_t)l * D * 2 * DFF, D, 2 * DFF, (half_t*)(lw + LW_UP1), 1);
        PRO_JOB((const float*)args.in[7] + (size_t)l * DFF * D, DFF, D, (half_t*)(lw + LW_DN1), 0);
        PRO_JOB((const float*)args.in[8] + (size_t)l * D * IN_COLS, D, IN_COLS, (half_t*)(lw + LW_IN), 2);
        PRO_JOB((const float*)args.in[11] + (size_t)l * QL * 1152, QL, 1152, (half_t*)(lw + LW_UQ), 0);
        PRO_JOB((const float*)args.in[12] + (size_t)l * KVL * 1536, KVL, 1536, (half_t*)(lw + LW_UKV), 0);
        PRO_JOB((const float*)args.in[14] + (size_t)l * D * D, D, D, (half_t*)(lw + LW_BR), 0);
        PRO_JOB((const float*)args.in[15] + (size_t)l * D * D, D, D, (half_t*)(lw + LW_OUT), 0);
        PRO_JOB((const float*)args.in[16] + (size_t)l * D * 2 * DFF, D, 2 * DFF, (half_t*)(lw + LW_UP2), 1);
        PRO_JOB((const float*)args.in[17] + (size_t)l * DFF * D, DFF, D, (half_t*)(lw + LW_DN2), 0);
        PRO_JOB((const float*)args.in[13] + (size_t)l * D * 1024, D, 1024, (half_t*)(ws + WS_WMEM) + (size_t)l * 1024 * D, 0);
        { u32x4 z = {0u, 0u, 0u, 0u}; const size_t gt = (size_t)F.gw * 64 + F.lane, gs = (size_t)F.NGW * 64;
          u32x4* p1 = (u32x4*)((half_t*)(lw + LW_IN) + (size_t)2192 * D); for (size_t i = gt; i < (size_t)112 * D / 8; i += gs) p1[i] = z;
          u32x4* p2 = (u32x4*)((half_t*)(lw + LW_UQ) + (size_t)1152 * QL); for (size_t i = gt; i < (size_t)128 * QL / 8; i += gs) p2[i] = z; }
    }
    const size_t gt = (size_t)F.gw * 64 + F.lane, gs = (size_t)F.NGW * 64;
    cvt_f32_to_h16((const float*)args.in[0], (half_t*)(ws + WS_X16), (size_t)M * D / 8, gt, gs);
    cvt_f32_to_h16((const float*)args.in[1], (half_t*)(ws + WS_MEM16), (size_t)BATCH * MEML * D / 8, gt, gs);
    { const int* pos = (const int*)args.in[2]; float* cs = (float*)(ws + WS_CS);
      for (size_t i = gt; i < (size_t)M * 32; i += gs) { const int m = (int)(i >> 5), f = (int)(i & 31);
          double v = 1.0; for (int q = 0; q < f; ++q) v *= 0.7498942093324559;
          const float inv_freq = (float)v; const float ang = (float)pos[m] * inv_freq; float c, s; sincos_f32arg(ang, c, s);
          cs[(size_t)m * 64 + f] = c; cs[(size_t)m * 64 + 32 + f] = s; } }
    if (F.gw == 0) { int* lut = (int*)(ws + WS_LUT);
#undef args
        for (int n = F.lane; n <= 128; n += 64) { int bkt; if (n < 16) bkt = n; else { const float lg2 = __builtin_amdgcn_logf((float)n * (1.0f / 16.0f)); int lg = 16 + (int)(lg2 * (16.0f / 3.0f)); bkt = lg < 31 ? lg : 31; } lut[n] = bkt; } }
}

__device__ __forceinline__ void phase_ln(const Frame& F0, const half_t* pre, const float* g, const float* b, half_t* x16, float* fout) {
    Frame F = F0; asm volatile("" : "+v"(F.lane)); asm volatile("" : "+s"(F.gw));
    for (int m = F.gw; m < M; m += F.NGW) {
        const h16x8* xr = (const h16x8*)(pre + (size_t)m * D) + F.lane;
        float v[4][8]; float s = 0.f;
#pragma unroll
        for (int j = 0; j < 4; ++j) { const h16x8 t = xr[64 * j];
#pragma unroll
            for (int e = 0; e < 8; ++e) { v[j][e] = (float)t[e]; s += v[j][e]; } }
        const float mean = wave_sum(s) * (1.f / D); float s2 = 0.f;
#pragma unroll
        for (int j = 0; j < 4; ++j)
#pragma unroll
            for (int e = 0; e < 8; ++e) { v[j][e] -= mean; s2 += v[j][e] * v[j][e]; }
        const float rstd = 1.0f / sqrtf(wave_sum(s2) * (1.f / D) + LN_EPS);
#pragma unroll
        for (int j = 0; j < 4; ++j) { const int c = 8 * (F.lane + 64 * j);
            const f32x4 g0 = *(const f32x4*)(g + c), g1 = *(const f32x4*)(g + c + 4), b0 = *(const f32x4*)(b + c), b1 = *(const f32x4*)(b + c + 4);
            f32x4 o0, o1;
#pragma unroll
            for (int e = 0; e < 4; ++e) { o0[e] = v[j][e] * rstd * g0[e] + b0[e]; o1[e] = v[j][4 + e] * rstd * g1[e] + b1[e]; }
            u32x4 w; w.x = pkh(o0[0], o0[1]); w.y = pkh(o0[2], o0[3]); w.z = pkh(o1[0], o1[1]); w.w = pkh(o1[2], o1[3]);
            *(u32x4*)(x16 + (size_t)m * D + c) = w;
            if (fout) { *(f32x4*)(fout + (size_t)m * D + c) = o0; *(f32x4*)(fout + (size_t)m * D + c + 4) = o1; } }
    }
}

__device__ __forceinline__ unsigned sortable(float f) { f = f + 0.0f; unsigned u = __builtin_bit_cast(unsigned, f); return (u & 0x80000000u) ? ~u : (u | 0x80000000u); }
__device__ __forceinline__ void phase_p5(const Frame& F0, const half_t* proj, const float* qn, const float* kvn, half_t* latn, half_t* krope, const float* cs, unsigned short* sel) {
    Frame F = F0; asm volatile("" : "+v"(F.lane)); asm volatile("" : "+s"(F.gw));
    for (int m = F.gw; m < M; m += F.NGW) {
        const half_t* pr = proj + (size_t)m * PROJ_LD;
#pragma unroll
        for (int w = 0; w < 2; ++w) {
            const h16x8 v = *(const h16x8*)(pr + (w ? PC_CKVL : PC_CQL) + 8 * F.lane);
            float f[8], s = 0.f;
#pragma unroll
            for (int j = 0; j < 8; ++j) { f[j] = (float)v[j]; s += f[j] * f[j]; }
            const float r = 1.0f / sqrtf(wave_sum(s) * (1.f / 512.f) + RMS_EPS);
            const float* gp = (w ? kvn : qn) + 8 * F.lane;
            u32x4 o; o.x = pkh(f[0] * r * gp[0], f[1] * r * gp[1]); o.y = pkh(f[2] * r * gp[2], f[3] * r * gp[3]); o.z = pkh(f[4] * r * gp[4], f[5] * r * gp[5]); o.w = pkh(f[6] * r * gp[6], f[7] * r * gp[7]);
            *(u32x4*)(latn + (size_t)m * LATN_LD + w * 512 + 8 * F.lane) = o;
        }
        if (F.lane < 32) { const float x1 = (float)pr[PC_KR + F.lane], x2 = (float)pr[PC_KR + 32 + F.lane]; const float c = cs[(size_t)m * 64 + F.lane], s = cs[(size_t)m * 64 + 32 + F.lane];
            krope[(size_t)m * ROPE + F.lane] = (half_t)(x1 * c - x2 * s); krope[(size_t)m * ROPE + 32 + F.lane] = (half_t)(x1 * s + x2 * c); }
    }
}
__device__ __forceinline__ void topk_select(const float (&sc)[32], int nk, int lane_, unsigned short* so, unsigned long long* sm) {
    int lane = lane_; asm volatile("" : "+v"(lane));
    unsigned u[32];
#pragma unroll
    for (int j = 0; j < 32; ++j) { const int s = 64 * j + lane; u[j] = (s < nk) ? sortable(sc[j]) : 0u; }
    const int nblk = (nk + 511) >> 9;
    unsigned prefix = 0u;
#pragma unroll 1
    for (int bit = 31; bit >= 0; --bit) { const unsigned cand = prefix | (1u << bit); int cnt = 0;
#pragma unroll
        for (int bq = 0; bq < 4; ++bq) if (bq < nblk) {
#pragma unroll
            for (int j = 8 * bq; j < 8 * bq + 8; ++j) cnt += __popcll(__ballot(u[j] >= cand)); }
        if (cnt >= TOPK) { prefix = cand; if (cnt == TOPK) break; } }
    int cgt = 0;
#pragma unroll
    for (int bq = 0; bq < 4; ++bq) if (bq < nblk) {
#pragma unroll
        for (int j = 8 * bq; j < 8 * bq + 8; ++j) cgt += __popcll(__ballot(u[j] > prefix)); }
    int need = TOPK - cgt;
    int pos = 0;
    const unsigned long long lt_mask = (1ull << lane) - 1ull;
#pragma unroll
    for (int j = 0; j < 32; ++j) {
        const unsigned long long beq = __ballot(u[j] == prefix);
        const int rank_eq = __popcll(beq & lt_mask);
        const bool pick = (u[j] > prefix) || (u[j] == prefix && rank_eq < need);
        const unsigned long long bp = __ballot(pick);
        if (pick) so[pos + __popcll(bp & lt_mask)] = (unsigned short)(64 * j + lane);
        if (lane == 0) sm[j] = bp;
        pos += __popcll(bp);
        const int neq = __popcll(beq); need = need > neq ? need - neq : 0;
    }
}
__device__ __forceinline__ void phase_indexer(const Frame& F0, const half_t* proj, unsigned short* sel, unsigned long long* selm) {
    Frame F = F0; asm volatile("" : "+v"(F.lane)); asm volatile("" : "+v"(F.tid)); asm volatile("" : "+s"(F.wave));
    const int lane = F.lane, tid = F.tid, wave = F.wave, g4 = lane >> 4, l15 = lane & 15, hi = lane >> 5, mid = (lane >> 4) & 1;
    LAS unsigned char* lds = F.lds;
    constexpr int CHB = 256 * 128;
    const int srow = tid >> 1, spc = (tid & 1) * 4;
    int bid = blockIdx.x; asm volatile("" : "+s"(bid));
#pragma unroll 1
    for (int gi = bid; gi < BATCH * 128; gi += F.G) {
        const int b = gi >> 7, rr = gi & 127, tg = ((gi >> 8) & 1) ? 127 - rr : rr;
        const int t0 = 16 * tg;
        if (t0 < TOPK) {
#pragma unroll 1
            for (int tk = 0; tk < 2; ++tk) { const int t = t0 + 8 * tk + wave, m = b * SEQ + t, nk = t + 1;
                unsigned short* so = sel + (size_t)m * TOPK; unsigned long long* sm = selm + (size_t)m * 32;
                for (int j = lane; j < TOPK; j += 64) so[j] = (unsigned short)(j < nk ? j : 0);
                if (lane < 32) { const int lo_ = 64 * lane; sm[lane] = (nk >= lo_ + 64) ? ~0ull : (nk > lo_ ? ((1ull << (nk - lo_)) - 1ull) : 0ull); } }
            continue;
        }
        const int tA = t0 + wave, tB = t0 + 8 + wave;
        const half_t* prA = proj + (size_t)(b * SEQ + tA) * PROJ_LD; const half_t* prB = proj + (size_t)(b * SEQ + tB) * PROJ_LD;
        h16x8 afA[2], afB[2]; float wA[4], wB[4];
#pragma unroll
        for (int ks = 0; ks < 2; ++ks) { afA[ks] = *(const h16x8*)(prA + PC_IQ + l15 * 64 + 32 * ks + 8 * g4); afB[ks] = *(const h16x8*)(prB + PC_IQ + l15 * 64 + 32 * ks + 8 * g4); }
#pragma unroll
        for (int r = 0; r < 4; ++r) { wA[r] = (float)prA[PC_IW + 4 * g4 + r]; wB[r] = (float)prB[PC_IW + 4 * g4 + r]; }
        float scA[32], scB[32];
#pragma unroll
        for (int j = 0; j < 32; ++j) { scA[j] = 0.f; scB[j] = 0.f; }
        const int nch = (t0 + 15) / 256 + 1;
        u32x4 kreg[4];
        const half_t* kbase = proj + (size_t)(b * SEQ + srow) * PROJ_LD + PC_IK + 8 * spc;
#define IDX_ISSUE(ch) do { const half_t* kp = kbase + (size_t)(ch) * 256 * PROJ_LD; _Pragma("unroll") for (int k = 0; k < 4; ++k) kreg[k] = *(const u32x4*)(kp + 8 * k); } while (0)
#define IDX_WRITE(buf) do { _Pragma("unroll") for (int k = 0; k < 4; ++k) *(LAS u32x4*)(lds + (buf) * CHB + srow * 128 + (((spc + k) ^ ((srow >> 1) & 7)) << 4)) = kreg[k]; } while (0)
        __syncthreads();
        IDX_ISSUE(0); IDX_WRITE(0);
        __syncthreads();
#pragma unroll
        for (int g = 0; g < 8; ++g) {
            if (g < nch) {
                if (g + 1 < nch) IDX_ISSUE(g + 1);
                LAS unsigned char* cb = lds + (g & 1) * CHB;
#pragma unroll
                for (int q = 0; q < 4; ++q) {
                    float pA[4], pB[4];
#pragma unroll
                    for (int k4 = 0; k4 < 4; ++k4) {
                        const int row = 16 * (4 * q + k4) + l15; const int sw = (row >> 1) & 7;
                        const h16x8 b0 = *(const LAS h16x8*)(cb + row * 128 + ((g4 ^ sw) << 4)), b1 = *(const LAS h16x8*)(cb + row * 128 + (((g4 + 4) ^ sw) << 4));
                        f32x4 dA = {0.f, 0.f, 0.f, 0.f}, dB = {0.f, 0.f, 0.f, 0.f};
                        dA = __builtin_amdgcn_mfma_f32_16x16x32_f16(afA[0], b0, dA, 0, 0, 0); dB = __builtin_amdgcn_mfma_f32_16x16x32_f16(afB[0], b0, dB, 0, 0, 0);
                        dA = __builtin_amdgcn_mfma_f32_16x16x32_f16(afA[1], b1, dA, 0, 0, 0); dB = __builtin_amdgcn_mfma_f32_16x16x32_f16(afB[1], b1, dB, 0, 0, 0);
                        pA[k4] = (wA[0] * fmaxf(dA[0], 0.f) + wA[1] * fmaxf(dA[1], 0.f)) + (wA[2] * fmaxf(dA[2], 0.f) + wA[3] * fmaxf(dA[3], 0.f));
                        pB[k4] = (wB[0] * fmaxf(dB[0], 0.f) + wB[1] * fmaxf(dB[1], 0.f)) + (wB[2] * fmaxf(dB[2], 0.f) + wB[3] * fmaxf(dB[3], 0.f));
                    }
                    { const float sendA = hi ? pA[0] : pA[2], sendB = hi ? pA[1] : pA[3];
                      const float keepA = (hi ? pA[2] : pA[0]) + xshfl_f(sendA, 32, lane), keepB = (hi ? pA[3] : pA[1]) + xshfl_f(sendB, 32, lane);
                      const float send = mid ? keepA : keepB; scA[4 * g + q] = (mid ? keepB : keepA) + xshfl_f(send, 16, lane); }
                    { const float sendA = hi ? pB[0] : pB[2], sendB = hi ? pB[1] : pB[3];
                      const float keepA = (hi ? pB[2] : pB[0]) + xshfl_f(sendA, 32, lane), keepB = (hi ? pB[3] : pB[1]) + xshfl_f(sendB, 32, lane);
                      const float send = mid ? keepA : keepB; scB[4 * g + q] = (mid ? keepB : keepA) + xshfl_f(send, 16, lane); }
                }
                if (g + 1 < nch) IDX_WRITE((g + 1) & 1);
                __syncthreads();
            }
        }
#undef IDX_ISSUE
#undef IDX_WRITE
        { int mA = b * SEQ + tA; asm volatile("" : "+s"(mA));
          topk_select(scA, tA + 1, lane, sel + (size_t)mA * TOPK, selm + (size_t)mA * 32); }
        { int mB = b * SEQ + tB; asm volatile("" : "+s"(mB));
          topk_select(scB, tB + 1, lane, sel + (size_t)mB * TOPK, selm + (size_t)mB * 32); }
        asm volatile("" ::: "memory");
    }
    __syncthreads();
}

template <int NH, bool IS_A>
__device__ __forceinline__ void phase_gattn(const Frame& F0, const half_t* proj, const half_t* memkv, const unsigned short* sel, const int* pos, const float* relb, const int* lut, half_t* ocat) {
    Frame F = F0; asm volatile("" : "+v"(F.lane)); asm volatile("" : "+s"(F.gw));
    LAS unsigned char* wl = F.lds + F.wave * 16384;
    LAS half_t* q_l = (LAS half_t*)wl;
    LAS float* p_l = (LAS float*)(wl + 2048);
    LAS unsigned* idx_l = (LAS unsigned*)(wl + 2048 + 8192);
    LAS float* rb_l = (LAS float*)(wl + 2048 + 8192 + 1024);
    const float scale = 0.08838834764831845f;
    if (IS_A) { for (int i = F.lane; i < 32 * 8; i += 64) rb_l[i] = ((i & 7) < A_HEADS) ? relb[(i >> 3) * A_HEADS + (i & 7)] : 0.f; }
    for (int m = F.gw; m < M; m += F.NGW) {
        const int b = m / SEQ, t = m % SEQ;
        const int nk = IS_A ? (t + 1 < TOPK ? t + 1 : TOPK) : MEML;
        const half_t* qp = proj + (size_t)m * PROJ_LD + (IS_A ? PC_AQ : PC_CQ);
        for (int i = F.lane; i < NH * 16; i += 64) *(LAS u32x4*)(q_l + 8 * i) = *(const u32x4*)(qp + 8 * i);
        for (int j = F.lane; j < 256; j += 64) idx_l[j] = IS_A ? (unsigned)(b * SEQ + sel[(size_t)m * TOPK + j]) : (unsigned)(b * MEML + j);
        LDS_WAIT(); asm volatile("" ::: "memory");
        const int pq = IS_A ? pos[m] : 0;
        float lg[4][NH];
#pragma unroll
        for (int i = 0; i < 4; ++i) {
            const int j = i * 64 + F.lane; const bool valid = j < nk; const unsigned row = idx_l[valid ? j : 0];
            float bias[NH];
#pragma unroll
            for (int h = 0; h < NH; ++h) bias[h] = 0.f;
            if (IS_A) { int dist = pq - pos[row]; dist = dist < 0 ? 0 : (dist > 128 ? 128 : dist); const int bk = lut[dist];
#pragma unroll
                for (int h = 0; h < NH; ++h) bias[h] = rb_l[bk * 8 + h]; }
            if (IS_A) {
                const half_t* kp = proj + (size_t)row * PROJ_LD + PC_AK;
                float d[NH];
#pragma unroll
                for (int h = 0; h < NH; ++h) d[h] = 0.f;
#pragma unroll 4
                for (int c = 0; c < 16; ++c) { const h16x8 kv = *(const h16x8*)(kp + 8 * c);
#pragma unroll
                    for (int h = 0; h < NH; ++h) { const h16x8 qv = *(const LAS h16x8*)(q_l + h * 128 + 8 * c);
#pragma unroll
                        for (int e = 0; e < 4; ++e) { h16x2 qa, ka; qa.x = qv[2 * e]; qa.y = qv[2 * e + 1]; ka.x = kv[2 * e]; ka.y = kv[2 * e + 1]; d[h] = __builtin_amdgcn_fdot2(qa, ka, d[h], false); } } }
#pragma unroll
                for (int h = 0; h < NH; ++h) lg[i][h] = valid ? d[h] * scale + bias[h] : -INFINITY;
            } else {
#pragma unroll
                for (int h = 0; h < NH; ++h) { const half_t* kp = memkv + (size_t)row * 4096 + h * 128; float d = 0.f;
#pragma unroll 4
                    for (int c = 0; c < 16; ++c) { const h16x8 kv = *(const h16x8*)(kp + 8 * c); const h16x8 qv = *(const LAS h16x8*)(q_l + h * 128 + 8 * c);
#pragma unroll
                        for (int e = 0; e < 4; ++e) { h16x2 qa, ka; qa.x = qv[2 * e]; qa.y = qv[2 * e + 1]; ka.x = kv[2 * e]; ka.y = kv[2 * e + 1]; d = __builtin_amdgcn_fdot2(qa, ka, d, false); } }
                    lg[i][h] = valid ? d * scale : -INFINITY; }
            }
        }
#pragma unroll
        for (int h = 0; h < NH; ++h) {
            float mx = fmaxf(fmaxf(lg[0][h], lg[1][h]), fmaxf(lg[2][h], lg[3][h])); mx = wave_max(mx);
            float e[4], s = 0.f;
#pragma unroll
            for (int i = 0; i < 4; ++i) { e[i] = __expf(lg[i][h] - mx); s += e[i]; }
            s = wave_sum(s); const float inv = 1.0f / s;
#pragma unroll
            for (int i = 0; i < 4; ++i) p_l[(i * 64 + F.lane) * 8 + h] = e[i] * inv;
        }
        LDS_WAIT(); asm volatile("" ::: "memory");
        float o[NH][2];
#pragma unroll
        for (int h = 0; h < NH; ++h) { o[h][0] = 0.f; o[h][1] = 0.f; }
#pragma unroll 4
        for (int j = 0; j < nk; ++j) {
            const unsigned row = __builtin_amdgcn_readfirstlane(idx_l[j]);
            const f32x4 p0 = *(const LAS f32x4*)(p_l + j * 8), p1 = *(const LAS f32x4*)(p_l + j * 8 + 4);
            const float pp[8] = {p0[0], p0[1], p0[2], p0[3], p1[0], p1[1], p1[2], p1[3]};
            if (IS_A) { const h16x2 v = *(const h16x2*)(proj + (size_t)row * PROJ_LD + PC_AV + 2 * F.lane); const float v0 = (float)v.x, v1 = (float)v.y;
#pragma unroll
                for (int h = 0; h < NH; ++h) { o[h][0] += pp[h] * v0; o[h][1] += pp[h] * v1; } }
            else {
#pragma unroll
                for (int h = 0; h < NH; ++h) { const h16x2 v = *(const h16x2*)(memkv + (size_t)row * 4096 + 512 + h * 128 + 2 * F.lane); o[h][0] += pp[h] * (float)v.x; o[h][1] += pp[h] * (float)v.y; } }
        }
        half_t* op = ocat + (size_t)m * D + (IS_A ? 0 : 1536);
#pragma unroll
        for (int h = 0; h < NH; ++h) *(unsigned*)(op + h * 128 + 2 * F.lane) = pkh(o[h][0], o[h][1]);
        asm volatile("" ::: "memory");
    }
}

__device__ __forceinline__ void phase_battn(const Frame& F0, const half_t* qb, const half_t* kvb, const half_t* krope, const float* cs, half_t* ocat) {
    Frame F = F0; asm volatile("" : "+v"(F.lane)); asm volatile("" : "+v"(F.tid)); asm volatile("" : "+s"(F.wave));
    constexpr int KROW = 200;
    LAS half_t* k_l = (LAS half_t*)F.lds;
    LAS half_t* v_l = (LAS half_t*)(F.lds + 25600);
    LAS half_t* q_l = (LAS half_t*)(F.lds + 25600 + 16384) + F.wave * 192;
    const float scale = 0.07216878364870322f;
    const int ntask = BATCH * B_HEADS * (SEQ / 8);
    for (int task = blockIdx.x; task < ntask; task += F.G) {
        const int tt = (SEQ / 8 - 1) - task / (BATCH * B_HEADS); const int bh = task % (BATCH * B_HEADS); const int b = bh / B_HEADS, h = bh % B_HEADS;
        const int t = tt * 8 + F.wave, m = b * SEQ + t;
        { const half_t* qp = qb + (size_t)m * QB_LD + h * 192;
          for (int i = F.lane; i < 128; i += 64) q_l[i] = qp[i];
          if (F.lane < 32) { const float x1 = (float)qp[128 + F.lane], x2 = (float)qp[160 + F.lane]; const float c = cs[(size_t)m * 64 + F.lane], s = cs[(size_t)m * 64 + 32 + F.lane];
              q_l[128 + F.lane] = (half_t)(x1 * c - x2 * s); q_l[160 + F.lane] = (half_t)(x1 * s + x2 * c); } }
        float mx = -INFINITY, l = 0.f, o0 = 0.f, o1 = 0.f;
        const int nchunk = (tt * 8 + 8 + 63) / 64;
        for (int c = 0; c < nchunk; ++c) {
            __syncthreads();
            for (int i = F.tid; i < 64 * 24; i += NTHREADS) { const int r = i / 24, pc = i % 24; const int row = b * SEQ + c * 64 + r;
                const u32x4 v = (pc < 16) ? *(const u32x4*)(kvb + (size_t)row * KVB_LD + h * 256 + 8 * pc) : *(const u32x4*)(krope + (size_t)row * ROPE + 8 * (pc - 16));
                *(LAS u32x4*)(k_l + r * KROW + 8 * pc) = v; }
            for (int i = F.tid; i < 64 * 16; i += NTHREADS) { const int r = i / 16, pc = i % 16; const int row = b * SEQ + c * 64 + r;
                *(LAS u32x4*)(v_l + r * 128 + 8 * pc) = *(const u32x4*)(kvb + (size_t)row * KVB_LD + h * 256 + 128 + 8 * pc); }
            __syncthreads();
            const int s = c * 64 + F.lane; const bool valid = s <= t;
            float d = 0.f;
#pragma unroll 6
            for (int pc = 0; pc < 24; ++pc) { const h16x8 kv = *(const LAS h16x8*)(k_l + F.lane * KROW + 8 * pc); const h16x8 qv = *(const LAS h16x8*)(q_l + 8 * pc);
#pragma unroll
                for (int e = 0; e < 4; ++e) { h16x2 qa, ka; qa.x = qv[2 * e]; qa.y = qv[2 * e + 1]; ka.x = kv[2 * e]; ka.y = kv[2 * e + 1]; d = __builtin_amdgcn_fdot2(qa, ka, d, false); } }
            const float lgt = valid ? d * scale : -INFINITY;
            const float mn = fmaxf(mx, wave_max(lgt));
            const float corr = __expf(mx - mn); const float p = __expf(lgt - mn);
            l = l * corr + wave_sum(p); o0 *= corr; o1 *= corr; mx = mn;
#pragma unroll 8
            for (int j = 0; j < 64; ++j) { const float pj = __shfl(p, j); const h16x2 v = *(const LAS h16x2*)(v_l + j * 128 + 2 * F.lane); o0 += pj * (float)v.x; o1 += pj * (float)v.y; }
        }
        const float inv = 1.0f / l;
        *(unsigned*)(ocat + (size_t)m * D + 768 + h * 128 + 2 * F.lane) = pkh(o0 * inv, o1 * inv);
    }
    __syncthreads();
}

typedef float f32x16 __attribute__((ext_vector_type(16)));
typedef short s16x4v __attribute__((__vector_size__(4 * sizeof(short))));
__device__ __forceinline__ h16x4 lds_tr_read(LAS unsigned char* p) { s16x4v r = __builtin_amdgcn_ds_read_tr16_b64_v4i16((LAS s16x4v*)p); return __builtin_bit_cast(h16x4, r); }
struct AttnSrc {
    const half_t* q; int q_ld, q_hs;
    const half_t* k0; int k0_ld, k0_hs;
    const half_t* k1; int k1_ld;
    const half_t* v; int v_ld, v_hs;
    half_t* o; int o_ld, o_off;
    int nheads, kv_rows;
    float scale; const float* cs;
    const unsigned long long* selm; const int* pos; const float* relb; const int* lut;
    int rev;
};
template <int DQK, bool CAUSAL, int MODE>
__device__ __forceinline__ void phase_attn_mfma(const Frame& F0, const AttnSrc& T) {
    Frame F = F0; asm volatile("" : "+v"(F.lane)); asm volatile("" : "+v"(F.tid)); asm volatile("" : "+s"(F.wave));
    constexpr int NKS = DQK / 16, KROWB = (DQK == 192) ? 400 : 272, VROWB = 320, KBYTES = 64 * KROWB, VBYTES = 64 * VROWB, BUF = KBYTES + VBYTES + 256;
    constexpr int KPT = DQK / 64, VPT = 2;
    constexpr int BL_OFF = 2 * BUF;
    static_assert(2 * BUF + 1024 <= RING_BYTES, "attention LDS");
    const int lane = F.lane, hh = lane >> 5, l31 = lane & 31, wave = F.wave, tid = F.tid;
    int bid = T.rev ? (int)(gridDim.x - 1 - blockIdx.x) : (int)blockIdx.x; asm volatile("" : "+s"(bid));
    LAS unsigned char* lds = F.lds;
    const float c = T.scale * 1.4426950408889634f;
    const int nbh = BATCH * T.nheads, nunits = nbh * 8;
    const int sr = tid >> 3, sp0 = tid & 7;
    const int trofs = (4 * hh + ((lane & 15) >> 2)) * VROWB + (16 * ((lane >> 4) & 1) + 4 * (lane & 3)) * 2;
    const int kofs = l31 * KROWB + 16 * hh;
#pragma unroll 1
    for (int round = 0;; ++round) {
        int u;
        if (CAUSAL && F.G == 256 && nunits == 384) { if (round == 0) u = bid; else if (round == 1 && bid >= 128) u = 511 - bid; else break; }
        else { u = bid + round * F.G; if (u >= nunits) break; }
        const int qblk = CAUSAL ? 7 - u / nbh : u / nbh; const int bh = u % nbh; const int b = bh / T.nheads, h = bh % T.nheads;
        const int R0 = 256 * qblk + 32 * wave;
        const size_t mrow = (size_t)b * SEQ + R0 + l31;
        h16x8 qf[NKS];
        { const half_t* qp = T.q + mrow * T.q_ld + h * T.q_hs + 8 * hh;
#pragma unroll
          for (int ks = 0; ks < NKS; ++ks) qf[ks] = *(const h16x8*)(qp + 16 * ks); }
        if (DQK == 192) {
            const float* csr = T.cs + mrow * 64;
#pragma unroll
            for (int a = 0; a < 2; ++a)
#pragma unroll
                for (int j = 0; j < 8; ++j) { const int idx = 16 * a + 8 * hh + j; const float cv = csr[idx], sv = csr[32 + idx]; const float x1 = (float)qf[8 + a][j], x2 = (float)qf[10 + a][j];
                    qf[8 + a][j] = (half_t)(x1 * cv - x2 * sv); qf[10 + a][j] = (half_t)(x1 * sv + x2 * cv); }
        }
        f32x16 o[4];
#pragma unroll
        for (int dt = 0; dt < 4; ++dt)
#pragma unroll
            for (int r = 0; r < 16; ++r) o[dt][r] = 0.f;
        float mrun = -1e30f, lsum = 0.f;
        const int ntiles = CAUSAL ? 4 * (qblk + 1) : T.kv_rows / 64;
        const int my_last = CAUSAL ? 4 * qblk + (wave >> 1) : ntiles - 1;
        const size_t kvrow0 = (size_t)b * T.kv_rows;
        u32x4 kreg[KPT], vreg[VPT], preg;
        int posq = 0, posq_min = 0; unsigned long long wnext = 0ull; const unsigned long long* selrow = nullptr;
        if (MODE == 1) { posq = T.pos[mrow]; posq_min = posq;
#pragma unroll
            for (int of = 1; of < 64; of <<= 1) { const int other = xshfl_i(posq_min, of, lane); posq_min = other < posq_min ? other : posq_min; }
            selrow = T.selm + mrow * 32; wnext = selrow[0]; }
#define ATT_ISSUE(j) do { const size_t row = kvrow0 + 64 * (j) + sr; const half_t* pk0 = T.k0 + row * T.k0_ld + h * T.k0_hs + 8 * sp0; const half_t* pk1 = (DQK == 192) ? T.k1 + row * T.k1_ld + 8 * sp0 : pk0; \
            const half_t* pv = T.v + row * T.v_ld + h * T.v_hs + 8 * sp0; \
            _Pragma("unroll") for (int k = 0; k < KPT; ++k) kreg[k] = (k < 2) ? *(const u32x4*)(pk0 + 64 * k) : *(const u32x4*)(pk1); \
            _Pragma("unroll") for (int k = 0; k < VPT; ++k) vreg[k] = *(const u32x4*)(pv + 64 * k); \
            if (MODE == 1) preg = *(const u32x4*)(T.pos + kvrow0 + 64 * (j) + 4 * (tid & 15)); } while (0)
#define ATT_WRITE(buf) do { LAS unsigned char* wb = lds + (buf) * BUF + sp0 * 16; _Pragma("unroll") for (int k = 0; k < KPT; ++k) *(LAS u32x4*)(wb + sr * KROWB + k * 128) = kreg[k]; \
        _Pragma("unroll") for (int k = 0; k < VPT; ++k) *(LAS u32x4*)(wb + KBYTES + sr * VROWB + k * 128) = vreg[k]; \
        if (MODE == 1) { if (tid < 16) *(LAS u32x4*)(lds + (buf) * BUF + KBYTES + VBYTES + tid * 16) = preg; } } while (0)
        __syncthreads();
        if (MODE == 1) { if (tid <= 128) ((LAS float*)(lds + BL_OFF))[tid] = T.relb[T.lut[tid] * A_HEADS + h] * 1.4426950408889634f; }
        ATT_ISSUE(0); ATT_WRITE(0);
        __syncthreads();
        const float bl31 = (MODE == 1) ? ((const LAS float*)(lds + BL_OFF))[128] : 0.f;
#pragma unroll 1
        for (int j = 0; j < ntiles; ++j) {
            const int buf = j & 1;
            if (j + 1 < ntiles) ATT_ISSUE(j + 1);
            if (j <= my_last) {
                LAS unsigned char* kb = lds + buf * BUF;
                unsigned long long wsel = 0ull;
                if (MODE == 1) { wsel = wnext; if (j < my_last) wnext = selrow[j + 1]; }
                f32x16 s0, s1;
#pragma unroll
                for (int r = 0; r < 16; ++r) { s0[r] = 0.f; s1[r] = 0.f; }
#pragma unroll
                for (int ks = 0; ks < NKS; ++ks) {
                    const h16x8 a0 = *(const LAS h16x8*)(kb + kofs + ks * 32), a1 = *(const LAS h16x8*)(kb + kofs + 32 * KROWB + ks * 32);
                    s0 = __builtin_amdgcn_mfma_f32_32x32x16_f16(a0, qf[ks], s0, 0, 0, 0);
                    s1 = __builtin_amdgcn_mfma_f32_32x32x16_f16(a1, qf[ks], s1, 0, 0, 0);
                }
                if (MODE == 1) {
                    const LAS int* pk = (const LAS int*)(kb + KBYTES + VBYTES);
                    int pkmax = pk[lane];
#pragma unroll
                    for (int of = 1; of < 64; of <<= 1) { const int other = xshfl_i(pkmax, of, lane); pkmax = other > pkmax ? other : pkmax; }
                    if (posq_min - pkmax >= 128) {
#pragma unroll
                        for (int r = 0; r < 16; ++r) { s0[r] = s0[r] * c + bl31; s1[r] = s1[r] * c + bl31; }
                    } else {
                        const LAS float* bl = (const LAS float*)(lds + BL_OFF);
#pragma unroll
                        for (int g = 0; g < 4; ++g) {
                            const i32x4 pa = *(const LAS i32x4*)(pk + 8 * g + 4 * hh), pb = *(const LAS i32x4*)(pk + 32 + 8 * g + 4 * hh);
                            const int pav[4] = {pa[0], pa[1], pa[2], pa[3]}, pbv[4] = {pb[0], pb[1], pb[2], pb[3]};
#pragma unroll
                            for (int e = 0; e < 4; ++e) { int d0 = posq - pav[e]; d0 = d0 < 0 ? 0 : (d0 > 128 ? 128 : d0); int d1 = posq - pbv[e]; d1 = d1 < 0 ? 0 : (d1 > 128 ? 128 : d1);
                                s0[4 * g + e] = s0[4 * g + e] * c + bl[d0]; s1[4 * g + e] = s1[4 * g + e] * c + bl[d1]; }
                        }
                    }
                    const unsigned wl = (unsigned)(wsel >> (4 * hh)), wh = (unsigned)(wsel >> (32 + 4 * hh));
#pragma unroll
                    for (int r = 0; r < 16; ++r) { const unsigned bitc = 1u << (8 * (r >> 2) + (r & 3)); if (!(wl & bitc)) s0[r] = -INFINITY; if (!(wh & bitc)) s1[r] = -INFINITY; }
                } else {
#pragma unroll
                    for (int r = 0; r < 16; ++r) { s0[r] *= c; s1[r] *= c; }
                    if (CAUSAL && j == my_last) {
                        const int qi = R0 + l31, k0i = 64 * j + 4 * hh;
#pragma unroll
                        for (int r = 0; r < 16; ++r) { const int key = k0i + 8 * (r >> 2) + (r & 3); if (key > qi) s0[r] = -INFINITY; if (key + 32 > qi) s1[r] = -INFINITY; }
                    }
                }
                float mx = fmaxf(s0[0], s1[0]);
#pragma unroll
                for (int r = 1; r < 16; ++r) mx = fmaxf(mx, fmaxf(s0[r], s1[r]));
                mx = fmaxf(mx, xshfl_f(mx, 32, lane));
                const float mnew = fmaxf(mrun, mx); const float alpha = __builtin_amdgcn_exp2f(mrun - mnew); mrun = mnew;
                float ps = 0.f;
#pragma unroll
                for (int r = 0; r < 16; ++r) { s0[r] = __builtin_amdgcn_exp2f(s0[r] - mnew); s1[r] = __builtin_amdgcn_exp2f(s1[r] - mnew); ps += s0[r] + s1[r]; }
                lsum = lsum * alpha + ps;
#pragma unroll
                for (int dt = 0; dt < 4; ++dt)
#pragma unroll
                    for (int r = 0; r < 16; ++r) o[dt][r] *= alpha;
                h16x8 pf[4];
#pragma unroll
                for (int sp = 0; sp < 4; ++sp)
#pragma unroll
                    for (int j2 = 0; j2 < 8; ++j2) pf[sp][j2] = (half_t)((sp >> 1) ? s1[8 * (sp & 1) + j2] : s0[8 * (sp & 1) + j2]);
                LAS unsigned char* vb = kb + KBYTES + trofs;
#pragma unroll
                for (int sp = 0; sp < 4; ++sp)
#pragma unroll
                    for (int dt = 0; dt < 4; ++dt) {
                        const h16x4 x = lds_tr_read(vb + sp * 16 * VROWB + dt * 64), y = lds_tr_read(vb + (sp * 16 + 8) * VROWB + dt * 64);
                        h16x8 av; av[0] = x[0]; av[1] = x[1]; av[2] = x[2]; av[3] = x[3]; av[4] = y[0]; av[5] = y[1]; av[6] = y[2]; av[7] = y[3];
                        o[dt] = __builtin_amdgcn_mfma_f32_32x32x16_f16(av, pf[sp], o[dt], 0, 0, 0);
                    }
            }
            if (j + 1 < ntiles) ATT_WRITE(buf ^ 1);
            __syncthreads();
        }
#undef ATT_ISSUE
#undef ATT_WRITE
        const float ltot = lsum + xshfl_f(lsum, 32, lane); const float inv = 1.0f / ltot;
        half_t* op = T.o + mrow * T.o_ld + T.o_off + h * 128 + 4 * hh;
#pragma unroll
        for (int dt = 0; dt < 4; ++dt)
#pragma unroll
            for (int g = 0; g < 4; ++g) { u32x2 w; w.x = pkh(o[dt][4 * g] * inv, o[dt][4 * g + 1] * inv); w.y = pkh(o[dt][4 * g + 2] * inv, o[dt][4 * g + 3] * inv);
                *(u32x2*)(op + 32 * dt + 8 * g) = w; }
    }
    __syncthreads();
}

constexpr int NP = 13, NPH = 2 + DEPTH * NP;
#define P_X16 ((half_t*)ap->p[PX_X16])
#define P_PROJ ((half_t*)ap->p[PX_R1])
#define P_H16 ((half_t*)ap->p[PX_R1])
#define P_PRE16 ((half_t*)ap->p[PX_PRELN])
#define P_GSUM ((half_t*)ap->p[PX_GSUM])
#define P_OCAT ((half_t*)ap->p[PX_OCAT])
#define P_QB ((half_t*)ap->p[PX_QB])
#define P_KVB ((half_t*)ap->p[PX_KVB])
#define P_LATN ((half_t*)ap->p[PX_LATN])
#define P_KROPE ((half_t*)ap->p[PX_KROPE])
#define P_TMPF ((float*)ap->p[PX_TMPF])
#define P_SEL ((unsigned short*)ap->p[PX_SEL])
#define P_CS ((const float*)ap->p[PX_CS])
#define P_MEMKV ((half_t*)ap->p[PX_MEMKV])
#define P_LUT ((const int*)ap->p[PX_LUT])
#define P_LWP(k) ((const half_t*)ap->lw[l][k])
#define PH_NOINLINE static __device__ __attribute__((noinline))
static __device__ __forceinline__ void ph_prologue(CArgs* ap, int wv) { Frame F = make_frame(wv); F.ws = ap->ws; for (int rep = 0; rep < REP_PRO; ++rep) phase_prologue(F, ap); }
PH_NOINLINE void ph_ln(CArgs* ap, int l, int which, int wv) {
    Frame F = make_frame(wv); unsigned char* ws = ap->ws;
    for (int rep = 0; rep < REP_LN; ++rep) phase_ln(F, P_PRE16, (const float*)ap->in[4] + (size_t)(l * 3 + which) * D, (const float*)ap->in[5] + (size_t)(l * 3 + which) * D, P_X16, (l == DEPTH - 1 && which == 2) ? ap->out : nullptr);
}
PH_NOINLINE void ph_p5(CArgs* ap, int l, int wv) {
    Frame F = make_frame(wv); unsigned char* ws = ap->ws;
    phase_p5(F, P_PROJ, (const float*)ap->in[9] + (size_t)l * QL, (const float*)ap->in[10] + (size_t)l * KVL, P_LATN, P_KROPE, P_CS, P_SEL);
}
static __device__ __forceinline__ void ph_indexer(CArgs* ap, int wv) {
    Frame F = make_frame(wv); unsigned char* ws = ap->ws;
    for (int rep = 0; rep < REP_IDX; ++rep) phase_indexer(F, P_PROJ, P_SEL, (unsigned long long*)ap->p[PX_SELM]);
}
static __device__ __forceinline__ void ph_attn_a(CArgs* ap, int wv) {
    Frame F = make_frame(wv); unsigned char* ws = ap->ws;
    AttnSrc T; T.q = P_PROJ + PC_AQ; T.q_ld = PROJ_LD; T.q_hs = 128; T.k0 = P_PROJ + PC_AK; T.k0_ld = PROJ_LD; T.k0_hs = 0; T.k1 = nullptr; T.k1_ld = 0;
    T.v = P_PROJ + PC_AV; T.v_ld = PROJ_LD; T.v_hs = 0; T.o = P_OCAT; T.o_ld = D; T.o_off = 0; T.nheads = A_HEADS; T.kv_rows = SEQ; T.scale = 0.08838834764831845f; T.cs = nullptr;
    T.selm = (const unsigned long long*)ap->p[PX_SELM]; T.pos = (const int*)ap->in[2]; T.relb = (const float*)ap->in[3]; T.lut = P_LUT; T.rev = 0;
    phase_attn_mfma<128, true, 1>(F, T);
}
static __device__ __forceinline__ void ph_attn_c(CArgs* ap, int l, int wv) {
    Frame F = make_frame(wv); unsigned char* ws = ap->ws;
    AttnSrc T; T.q = P_PROJ + PC_CQ; T.q_ld = PROJ_LD; T.q_hs = 128; T.k0 = P_MEMKV + (size_t)l * 1024; T.k0_ld = 4096; T.k0_hs = 128; T.k1 = nullptr; T.k1_ld = 0;
    T.v = P_MEMKV + (size_t)l * 1024 + 512; T.v_ld = 4096; T.v_hs = 128; T.o = P_OCAT; T.o_ld = D; T.o_off = 1536; T.nheads = C_HEADS; T.kv_rows = MEML; T.scale = 0.08838834764831845f; T.cs = nullptr;
    T.selm = nullptr; T.pos = nullptr; T.relb = nullptr; T.lut = nullptr; T.rev = 0;
    phase_attn_mfma<128, false, 0>(F, T);
}
static __device__ __forceinline__ void ph_attn_b(CArgs* ap, int wv) {
    Frame F = make_frame(wv); unsigned char* ws = ap->ws;
    AttnSrc T; T.q = P_QB; T.q_ld = QB_LD; T.q_hs = 192; T.k0 = P_KVB; T.k0_ld = KVB_LD; T.k0_hs = 256; T.k1 = P_KROPE; T.k1_ld = ROPE;
    T.v = P_KVB + 128; T.v_ld = KVB_LD; T.v_hs = 256; T.o = P_OCAT; T.o_ld = D; T.o_off = 768; T.nheads = B_HEADS; T.kv_rows = SEQ; T.scale = 0.07216878364870322f; T.cs = P_CS;
    T.selm = nullptr; T.pos = nullptr; T.relb = nullptr; T.lut = nullptr; T.rev = 1;
    for (int rep = 0; rep < REP_BA; ++rep) phase_attn_mfma<192, true, 0>(F, T);
}
#define SITE_PTRS() CArgs* ap = kap; asm volatile("" : "+s"(ap)); unsigned char* ws = ap->ws; (void)ws
__global__ void __launch_bounds__(NTHREADS, 2) fwd_kernel(Args args) {
    extern __shared__ __attribute__((aligned(16))) unsigned char lds_raw[];
    CArgs* kap = (CArgs*)__builtin_amdgcn_kernarg_segment_ptr();
    LAS unsigned char* const lds = (LAS unsigned char*)lds_raw;
    const int G = gridDim.x;
    const int wv = __builtin_amdgcn_readfirstlane((int)threadIdx.x >> 6);
    int wv0_ = wv; asm volatile("" : "+s"(wv0_)); const int tid0 = wv0_ * 64 + lane_id();
    volatile LAS unsigned* ctl_l = (volatile LAS unsigned*)(lds + LDSCTL_OFF);
    for (int u = tid0; u < (LDS_BYTES - LDSCTL_OFF) / 4; u += NTHREADS) ctl_l[u] = 0u;
    __syncthreads();
    const int lo = args.ph_lo, hi = args.ph_hi;
    XcdBarrier bar; bar.bar = (unsigned*)(args.ws + WS_CTL) + CW_BAR; bar.x = 0; bar.st = ctl_l + 8; bar.wave = wv;
    if (hi - lo > 1) {
        bar = xcd_barrier_post((unsigned*)(args.ws + WS_CTL) + CW_BAR, ctl_l + 8, wv);
        if (tid0 == 0) { unsigned nloc, nx; xcd_barrier_complete(bar.bar, bar.x, nloc, nx); bar.st[0] = nloc; bar.st[1] = nx; }
        __syncthreads();
    }
#define IN(k) (lo <= (k) && (k) < hi)
#define SEAM(k) do { if (IN((k) + 1)) xcd_barrier(bar); } while (0)

    if (IN(0)) { SITE_PTRS(); ph_prologue(ap, wv); SEAM(0); }
    if (IN(1)) {
        SITE_PTRS();
        pg8::Gemm g{(const half_t*)ap->p[PX_MEM16], (const half_t*)ap->p[PX_WMEM], D, D, D}; pg8::StaticOrder S; S.init(BATCH * MEML, 4096, G, (int)blockIdx.x);
        pg8::EpiH16 E; E.O = P_MEMKV; E.ldc = 4096; E.sig_from = 1 << 30;
        pg8::gemm_phase(lds, g, S, E, wv);
        SEAM(1);
    }
#pragma unroll 1
    for (int l = 0; l < DEPTH; ++l) {
        const int p0 = 2 + l * NP;
        if (p0 + NP <= lo || p0 >= hi) continue;
        if (IN(p0 + 0)) {
            SITE_PTRS();
            pg8::Gemm g{P_X16, P_LWP(LWX_UP1), D, D, D}; pg8::StaticOrder S; S.init(M, 2 * DFF, G, (int)blockIdx.x);
            pg8::EpiSwiglu E; E.H = P_H16; E.ldh = DFF;
            for (int rep = 0; rep < REP_UP; ++rep) pg8::gemm_phase(lds, g, S, E, wv);
            SEAM(p0 + 0);
        }
        if (IN(p0 + 1)) {
            SITE_PTRS();
            pg8::Gemm g{P_H16, P_LWP(LWX_DN1), DFF, DFF, DFF}; pg8::StaticOrder S; S.init(M, D, G, (int)blockIdx.x);
            pg8::EpiResid16 E; E.X = P_X16; E.O = P_PRE16; E.alpha = ALPHA; E.coef = 0.5f;
            pg8::gemm_phase(lds, g, S, E, wv); SEAM(p0 + 1);
        }
        if (IN(p0 + 2)) { ph_ln(kap, l, 0, wv); SEAM(p0 + 2); }
        if (IN(p0 + 3)) {
            SITE_PTRS();
            pg8::Gemm g{P_X16, P_LWP(LWX_IN), D, D, D}; pg8::StaticOrder S; S.init(M, PROJ_LD, G, (int)blockIdx.x);
            pg8::EpiH16 E; E.O = P_PROJ; E.ldc = PROJ_LD; E.sig_from = PC_GATES / 256;
            pg8::gemm_phase(lds, g, S, E, wv); SEAM(p0 + 3);
        }
        if (IN(p0 + 4)) { ph_p5(kap, l, wv); { SITE_PTRS(); ph_indexer(ap, wv); } SEAM(p0 + 4); }
        if (IN(p0 + 5)) {
            { SITE_PTRS(); pg8::Gemm g{P_LATN, P_LWP(LWX_UQ), LATN_LD, QL, QL}; pg8::StaticOrder S; S.init(M, QB_LD, G, (int)blockIdx.x);
              pg8::EpiH16 E; E.O = P_QB; E.ldc = QB_LD; E.sig_from = 1 << 30; pg8::gemm_phase(lds, g, S, E, wv); }
            { SITE_PTRS(); pg8::Gemm g{P_LATN + 512, P_LWP(LWX_UKV), LATN_LD, KVL, KVL}; pg8::StaticOrder S; S.init(M, KVB_LD, G, (int)blockIdx.x);
              pg8::EpiH16 E; E.O = P_KVB; E.ldc = KVB_LD; E.sig_from = 1 << 30; pg8::gemm_phase(lds, g, S, E, wv); }
            SEAM(p0 + 5);
        }
        if (IN(p0 + 6)) {
            { SITE_PTRS(); ph_attn_a(ap, wv); } { SITE_PTRS(); ph_attn_c(ap, l, wv); } { SITE_PTRS(); ph_attn_b(ap, wv); }
            SEAM(p0 + 6);
        }
        if (IN(p0 + 7)) {
            { SITE_PTRS(); pg8::Gemm g{P_OCAT, P_LWP(LWX_BR), D, D, 768}; pg8::StaticOrder S; S.init(M, D, G, (int)blockIdx.x);
              pg8::EpiBranch<0> E; E.G = P_PROJ + PC_GATES; E.ldg = PROJ_LD; E.T = P_TMPF; E.O = P_GSUM; pg8::gemm_phase(lds, g, S, E, wv); }
            { SITE_PTRS(); pg8::Gemm g{P_OCAT + 768, P_LWP(LWX_BR) + 768, D, D, 768}; pg8::StaticOrder S; S.init(M, D, G, (int)blockIdx.x);
              pg8::EpiBranch<1> E; E.G = P_PROJ + PC_GATES + D; E.ldg = PROJ_LD; E.T = P_TMPF; E.O = P_GSUM; pg8::gemm_phase(lds, g, S, E, wv); }
            { SITE_PTRS(); pg8::Gemm g{P_OCAT + 1536, P_LWP(LWX_BR) + 1536, D, D, 512}; pg8::StaticOrder S; S.init(M, D, G, (int)blockIdx.x);
              pg8::EpiBranch<2> E; E.G = P_PROJ + PC_GATES + 2 * D; E.ldg = PROJ_LD; E.T = P_TMPF; E.O = P_GSUM; pg8::gemm_phase(lds, g, S, E, wv); }
            SEAM(p0 + 7);
        }
        if (IN(p0 + 8)) {
            SITE_PTRS();
            pg8::Gemm g{P_GSUM, P_LWP(LWX_OUT), D, D, D}; pg8::StaticOrder S; S.init(M, D, G, (int)blockIdx.x);
            pg8::EpiResid16 E; E.X = P_X16; E.O = P_PRE16; E.alpha = ALPHA; E.coef = 1.0f;
            pg8::gemm_phase(lds, g, S, E, wv); SEAM(p0 + 8);
        }
        if (IN(p0 + 9)) { ph_ln(kap, l, 1, wv); SEAM(p0 + 9); }
        if (IN(p0 + 10)) {
            SITE_PTRS();
            pg8::Gemm g{P_X16, P_LWP(LWX_UP2), D, D, D}; pg8::StaticOrder S; S.init(M, 2 * DFF, G, (int)blockIdx.x);
            pg8::EpiSwiglu E; E.H = P_H16; E.ldh = DFF;
            for (int rep = 0; rep < REP_UP; ++rep) pg8::gemm_phase(lds, g, S, E, wv);
            SEAM(p0 + 10);
        }
        if (IN(p0 + 11)) {
            SITE_PTRS();
            pg8::Gemm g{P_H16, P_LWP(LWX_DN2), DFF, DFF, DFF}; pg8::StaticOrder S; S.init(M, D, G, (int)blockIdx.x);
            pg8::EpiResid16 E; E.X = P_X16; E.O = P_PRE16; E.alpha = ALPHA; E.coef = 0.5f;
            pg8::gemm_phase(lds, g, S, E, wv); SEAM(p0 + 11);
        }
        if (IN(p0 + 12)) { ph_ln(kap, l, 2, wv); SEAM(p0 + 12); }
    }
#undef IN
#undef SEAM
}

extern "C" void kernel_launch(void* const* d_in, const int* in_sizes, int n_in, void* d_out, int out_size, void* d_ws, size_t ws_size, hipStream_t stream) {
    static int grid = 0;
    if (grid == 0) {
        if (n_in != 18 || out_size != M * D || ws_size < WS_END) { fprintf(stderr, "kernel_launch: unexpected shapes (n_in %d out %d ws %zu need %zu)\n", n_in, out_size, ws_size, (size_t)WS_END); grid = -1; return; }
        int dev = 0, cus = 0, per_cu = 0;
        if (hipGetDevice(&dev) != hipSuccess || hipDeviceGetAttribute(&cus, hipDeviceAttributeMultiprocessorCount, dev) != hipSuccess) { grid = -1; return; }
        if (hipFuncSetAttribute((const void*)fwd_kernel, hipFuncAttributeMaxDynamicSharedMemorySize, LDS_BYTES) != hipSuccess) { fprintf(stderr, "kernel_launch: hipFuncSetAttribute failed\n"); grid = -1; return; }
        if (hipOccupancyMaxActiveBlocksPerMultiprocessor(&per_cu, (const void*)fwd_kernel, NTHREADS, LDS_BYTES) != hipSuccess || per_cu < 1) { fprintf(stderr, "kernel_launch: occupancy query says %d\n", per_cu); }
        (void)hipGetLastError();
        grid = cus;
    }
    if (grid < 0) return;
    (void)hipMemsetAsync((char*)d_ws + WS_CTL, 0, CTL_ZERO_BYTES, stream);
    Args a{};
    for (int i = 0; i < 18; ++i) a.in[i] = d_in[i];
    a.out = (float*)d_out; a.ws = (unsigned char*)d_ws;
    { unsigned char* w = (unsigned char*)d_ws;
      a.p[PX_X16] = w + WS_X16; a.p[PX_R1] = w + WS_R1; a.p[PX_PRELN] = w + WS_R1 + R1_PRELN; a.p[PX_OCAT] = w + WS_OCAT; a.p[PX_QB] = w + WS_QB; a.p[PX_KVB] = w + WS_KVB; a.p[PX_LATN] = w + WS_LATN;
      a.p[PX_KROPE] = w + WS_KROPE; a.p[PX_TMPF] = w + WS_TMP; a.p[PX_SEL] = w + WS_SEL; a.p[PX_CS] = w + WS_CS; a.p[PX_MEMKV] = w + WS_MEMKV; a.p[PX_LUT] = w + WS_LUT; a.p[PX_SELM] = w + WS_SELM;
      a.p[PX_MEM16] = w + WS_MEM16; a.p[PX_WMEM] = w + WS_WMEM; a.p[PX_GSUM] = w + WS_GSUM;
      const size_t lwo[LWX_N] = {LW_UP1, LW_DN1, LW_IN, LW_UQ, LW_UKV, LW_BR, LW_OUT, LW_UP2, LW_DN2};
      for (int l = 0; l < DEPTH; ++l) for (int k = 0; k < LWX_N; ++k) a.lw[l][k] = w + WS_W + (size_t)l * LW_END + lwo[k]; }
#if ONE_LAUNCH
    a.ph_lo = 0; a.ph_hi = NPH;
    hipLaunchKernelGGL(fwd_kernel, dim3(grid), dim3(NTHREADS), LDS_BYTES, stream, a);
#else
    for (int p = 0; p < NPH; ++p) { a.ph_lo = p; a.ph_hi = p + 1; hipLaunchKernelGGL(fwd_kernel, dim3(grid), dim3(NTHREADS), LDS_BYTES, stream, a); }
#endif
}
```

```cpp
#include <hip/hip_runtime.h>
#include <cstdio>
#include <cstdint>

#ifndef REP_UP
#define REP_UP 1
#endif
#ifndef REP_GA
#define REP_GA 1
#endif
#ifndef REP_PRO
#define REP_PRO 1
#endif
#ifndef REP_LN
#define REP_LN 1
#endif
#ifndef REP_BA
#define REP_BA 1
#endif
#ifndef REP_IDX
#define REP_IDX 1
#endif
#ifndef ONE_LAUNCH
#define ONE_LAUNCH 1
#endif

#define GAS __attribute__((address_space(1)))
#define LAS __attribute__((address_space(3)))
typedef _Float16 half_t;
typedef _Float16 h16x8 __attribute__((ext_vector_type(8)));
typedef _Float16 h16x4 __attribute__((ext_vector_type(4)));
typedef _Float16 h16x2 __attribute__((ext_vector_type(2)));
typedef float f32x4 __attribute__((ext_vector_type(4)));
typedef float f32x2 __attribute__((ext_vector_type(2)));
typedef unsigned u32x4 __attribute__((ext_vector_type(4)));
typedef unsigned u32x2 __attribute__((ext_vector_type(2)));
typedef int i32x4 __attribute__((ext_vector_type(4)));

constexpr int D = 2048, BATCH = 8, SEQ = 2048, M = BATCH * SEQ, DEPTH = 4, MEML = 256, HD = 128;
constexpr int A_HEADS = 6, IDX_HEADS = 16, IDX_DIM = 64, TOPK = 256, B_HEADS = 6, QL = 512, KVL = 512, NOPE = 128, ROPE = 64, VD = 128, C_HEADS = 4;
constexpr int DFF = 5632, IN_COLS = 9872, PROJ_LD = 9984;
constexpr int QB_LD = 1280, KVB_LD = 1536, LATN_LD = 1024;
constexpr float LN_EPS = 1e-5f, RMS_EPS = 1e-6f;
constexpr float ALPHA = 1.681792830507429f;
constexpr int PC_AQ = 0, PC_AK = 768, PC_AV = 896, PC_IQ = 1024, PC_IK = 2048, PC_KR = 2112, PC_IW = 2176, PC_CQL = 2304, PC_CKVL = 2816, PC_CQ = 3328, PC_GATES = 3840;
constexpr int NWAVES = 8, NTHREADS = 512;

constexpr size_t al256(size_t x) { return (x + 255) & ~(size_t)255; }
constexpr size_t WS_CTL = 0, CTL_ZERO_BYTES = 1u << 20;
constexpr size_t SZ_WUP = (size_t)2 * DFF * D * 2, SZ_WDN = (size_t)D * DFF * 2, SZ_WIN = (size_t)PROJ_LD * D * 2, SZ_WUQ = (size_t)QB_LD * QL * 2, SZ_WUKV = (size_t)KVB_LD * KVL * 2;
constexpr size_t SZ_WBR = (size_t)D * D * 2, SZ_WOUT = (size_t)D * D * 2;
constexpr size_t LW_UP1 = 0, LW_DN1 = LW_UP1 + SZ_WUP, LW_IN = LW_DN1 + SZ_WDN, LW_UQ = LW_IN + SZ_WIN, LW_UKV = LW_UQ + SZ_WUQ, LW_BR = LW_UKV + SZ_WUKV, LW_OUT = LW_BR + SZ_WBR,
                 LW_UP2 = LW_OUT + SZ_WOUT, LW_DN2 = LW_UP2 + SZ_WUP, LW_END = LW_DN2 + SZ_WDN;
constexpr size_t WS_W = CTL_ZERO_BYTES;
constexpr size_t WS_WMEM = WS_W + (size_t)DEPTH * LW_END;
constexpr size_t WS_X16 = WS_WMEM + (size_t)DEPTH * 1024 * D * 2;
constexpr size_t WS_R1 = WS_X16 + (size_t)M * D * 2;
constexpr size_t R1_PRELN = (size_t)M * DFF * 2;
constexpr size_t WS_OCAT = WS_R1 + (size_t)M * PROJ_LD * 2;
constexpr size_t WS_QB = WS_OCAT + (size_t)M * D * 2;
constexpr size_t WS_KVB = WS_QB + (size_t)M * QB_LD * 2;
constexpr size_t WS_LATN = WS_KVB + (size_t)M * KVB_LD * 2;
constexpr size_t WS_KROPE = WS_LATN + (size_t)M * LATN_LD * 2;
constexpr size_t WS_TMP = WS_KROPE + (size_t)M * ROPE * 2;
constexpr size_t WS_SEL = WS_TMP + (size_t)M * D * 4;
constexpr size_t WS_CS = WS_SEL + (size_t)M * TOPK * 2;
constexpr size_t WS_MEM16 = WS_CS + (size_t)M * 64 * 4;
constexpr size_t WS_MEMKV = WS_MEM16 + (size_t)BATCH * MEML * D * 2;
constexpr size_t WS_LUT = WS_MEMKV + (size_t)BATCH * MEML * 4096 * 2;
constexpr size_t WS_SELM = WS_LUT + 1024;
constexpr size_t WS_GSUM = WS_SELM + (size_t)M * 32 * 8;
constexpr size_t WS_END = WS_GSUM + (size_t)M * D * 2;
static_assert(R1_PRELN + (size_t)M * D * 4 <= (size_t)M * PROJ_LD * 2, "preLN fits behind h16");
static_assert(WS_W % 256 == 0 && LW_END % 256 == 0, "align");

constexpr int CW_BAR = 4096;

constexpr int RING_BYTES = 131072, LDSCTL_OFF = RING_BYTES, LDS_BYTES = 147456;

#define LDS_WAIT() asm volatile("s_waitcnt lgkmcnt(0)" ::: "memory")
#define VM_WAIT() asm volatile("s_waitcnt vmcnt(0)" ::: "memory")
__device__ __forceinline__ unsigned pkh(float lo, float hi) { h16x2 v; v.x = (half_t)lo; v.y = (half_t)hi; return __builtin_bit_cast(unsigned, v); }
__device__ __forceinline__ float wave_sum(float v) {
#pragma unroll
    for (int o = 1; o < 64; o <<= 1) v += __shfl_xor(v, o);
    return v;
}
__device__ __forceinline__ float wave_max(float v) {
#pragma unroll
    for (int o = 1; o < 64; o <<= 1) v = fmaxf(v, __shfl_xor(v, o));
    return v;
}
__device__ __forceinline__ float xshfl_f(float v, int mask, int lane) { return __builtin_bit_cast(float, __builtin_amdgcn_ds_bpermute((lane ^ mask) << 2, __builtin_bit_cast(int, v))); }
__device__ __forceinline__ int xshfl_i(int v, int mask, int lane) { return __builtin_amdgcn_ds_bpermute((lane ^ mask) << 2, v); }
__device__ __forceinline__ float fast_sigmoid(float x) { return __builtin_amdgcn_rcpf(1.0f + __builtin_amdgcn_exp2f(-1.4426950408889634f * x)); }

__device__ __forceinline__ int lane_id() { return (int)__builtin_amdgcn_mbcnt_hi(~0u, __builtin_amdgcn_mbcnt_lo(~0u, 0u)); }
#define XB_TMO      128
#define XB_XCNT(j)  (256  + 64 * (j))
#define XB_XSUB(j)  (1280 + 64 * (j))
#define XB_XGEN(j)  (2304 + 64 * (j))
#define XB_TOP      3328
#define XB_TOPGEN   3392
#define XCD_BAR_WORDS 3456
#define XB_SPIN_CAP (1u << 20)
__device__ __forceinline__ unsigned xb_ld(unsigned* p)              { return __hip_atomic_load(p, __ATOMIC_RELAXED, __HIP_MEMORY_SCOPE_AGENT); }
__device__ __forceinline__ unsigned xb_add(unsigned* p, unsigned v) { return __hip_atomic_fetch_add(p, v, __ATOMIC_RELAXED, __HIP_MEMORY_SCOPE_AGENT); }
__device__ __forceinline__ unsigned xb_xcc_id() { return (unsigned)__builtin_amdgcn_s_getreg((3 << 11) | 20) & 0xFu; }
#define XB_SPIN(cond, bar) do { unsigned _sp = 0; while (cond) { __builtin_amdgcn_s_sleep(1); \
    if ((++_sp & 255u) == 0u) { if (xb_ld(&(bar)[XB_TMO])) break; if (_sp > XB_SPIN_CAP) { atomicAdd(&(bar)[XB_TMO], 1u); break; } } } } while (0)
struct XcdBarrier { unsigned* bar; unsigned x; volatile LAS unsigned* st; int wave; };
#define xb_is_t0() (b.wave == 0 && __builtin_amdgcn_mbcnt_hi(~0u, __builtin_amdgcn_mbcnt_lo(~0u, 0u)) == 0u)
__device__ __forceinline__ XcdBarrier xcd_barrier_post(unsigned* bar, volatile LAS unsigned* st, int wave) {
    XcdBarrier b; b.bar = bar; b.x = xb_xcc_id(); b.st = st; b.wave = wave;
    if (xb_is_t0()) (void)xb_add(&bar[XB_XCNT(b.x)], 1u);
    return b;
}
__device__ __forceinline__ void xcd_barrier_complete(unsigned* bar, unsigned x, unsigned& nloc, unsigned& nx) {
    const unsigned G = gridDim.x * gridDim.y * gridDim.z;
    unsigned sum, cnt, mine, sp = 0u;
    for (;;) {
        sum = 0u; cnt = 0u; mine = 0u;
#pragma unroll
        for (unsigned j = 0; j < 16; ++j) { const unsigned c = xb_ld(&bar[XB_XCNT(j)]); sum += c; cnt += (c > 0u) ? 1u : 0u; mine = (j == x) ? c : mine; }
        if (sum == G) break;
        __builtin_amdgcn_s_sleep(1);
        if ((++sp & 255u) == 0u) { if (xb_ld(&bar[XB_TMO])) break; if (sp > XB_SPIN_CAP) { atomicAdd(&bar[XB_TMO], 1u); break; } }
    }
    nloc = mine > 0u ? mine : 1u; nx = cnt > 0u ? cnt : 1u;
}
__device__ __forceinline__ void xcd_barrier(const XcdBarrier& b) {
    asm volatile("s_waitcnt vmcnt(0)" ::: "memory");
    __syncthreads();
    if (xb_is_t0()) {
        unsigned* bar = b.bar;
        __builtin_amdgcn_s_waitcnt(0);
        const unsigned nloc = b.st[0], nx = b.st[1];
        const unsigned old = xb_add(&bar[XB_XSUB(b.x)], 1u);
        const unsigned gen = old / nloc;
        if (old + 1u == (gen + 1u) * nloc) {
            __builtin_amdgcn_fence(__ATOMIC_RELEASE, "agent");
            asm volatile("s_waitcnt vmcnt(0)" ::: "memory");
            const unsigned og = xb_add(&bar[XB_TOP], 1u);
            const unsigned tg = og / nx;
            if (og + 1u == (tg + 1u) * nx) xb_add(&bar[XB_TOPGEN], 1u);
            else XB_SPIN(xb_ld(&bar[XB_TOPGEN]) == tg, bar);
            __builtin_amdgcn_fence(__ATOMIC_ACQUIRE, "agent");
            xb_add(&bar[XB_XGEN(b.x)], 1u);
            asm volatile("s_waitcnt vmcnt(0)" ::: "memory");
        } else {
            XB_SPIN(xb_ld(&bar[XB_XGEN(b.x)]) == gen, bar);
            __builtin_amdgcn_fence(__ATOMIC_ACQUIRE, "agent");
            asm volatile("s_waitcnt vmcnt(0)" ::: "memory");
        }
    }
    __syncthreads();
}

namespace pg8 {
constexpr int BM = 256, BK = 64, HALF = 128, HTB = HALF * BK * 2, STAGE_BYTES = 8 * HTB, NXCD = 8, WGM = 8;
__host__ __device__ __forceinline__ int lds_byte(int r, int c) { const int st = (r >> 4) * 2 + (c >> 5), rr = r & 15, cc = c & 31, ob = rr * 64 + cc * 2; return st * 1024 + (ob ^ (((ob >> 9) & 1) << 5)); }
__host__ __device__ __forceinline__ void stage_rc(int b, int& R, int& C) { const int st = b / 1024, sb = b % 1024, swz = sb ^ (((sb >> 9) & 1) << 5); R = (st >> 1) * 16 + swz / 64; C = (st & 1) * 32 + (swz % 64) / 2; }
__host__ __device__ __forceinline__ int perm32(int rho) { const int n = rho >> 4, i = rho & 15; return 8 * (i >> 2) + 4 * n + (i & 3); }
struct Unit { int pm, pn; };
struct Gemm { const half_t* A; const half_t* Bt; int lda, ldb, K; };
struct StaticOrder {
    int nM, nN, nwg, G, c;
    __host__ __device__ void init(int M_, int N_, int G_, int c_) { nM = M_ / BM; nN = N_ / BM; nwg = nM * nN; G = G_; c = c_; }
    __host__ __device__ bool next(int i, Unit& u) const {
        const long L = (long)i * G + c; if (L >= nwg) return false;
        int wgid = (int)L; { const int q = nwg / NXCD, r = nwg % NXCD, xcd = wgid % NXCD, off = wgid / NXCD; wgid = (xcd < r ? xcd * (q + 1) : r * (q + 1) + (xcd - r) * q) + off; }
        const int nig = WGM * nN, gid = wgid / nig, fm = gid * WGM, gsz = (nM - fm) < WGM ? (nM - fm) : WGM;
        u.pm = fm + ((wgid % nig) % gsz); u.pn = (wgid % nig) / gsz; return true;
    }
};
template <class Epi>
__device__ __forceinline__ void gemm_phase(LAS unsigned char* lds, const Gemm g, const StaticOrder& S0, const Epi& E, int wave_) {
    StaticOrder S = S0; asm volatile("" : "+s"(S.c));
    int w_ = wave_; asm volatile("" : "+s"(w_)); int tid_ = w_ * 64 + lane_id(); asm volatile("" : "+v"(tid_));
    const int tid = tid_, wid = __builtin_amdgcn_readfirstlane(tid >> 6), lane = tid & 63, wr = wid >> 2, wc = wid & 3, fr = lane & 15, fq = lane >> 4;
    const int K = g.K, nt = K / BK;
    unsigned voffA[2], voffB[2];
#pragma unroll
    for (int i = 0; i < 2; ++i) { int R, C; stage_rc(tid * 16 + i * 8192, R, C); const int Rb = Epi::PERM ? ((R & ~31) + perm32(R & 31)) : R;
        voffA[i] = (unsigned)(R * g.lda + C) * 2u; voffB[i] = (unsigned)(Rb * g.ldb + C) * 2u; }
    const size_t kstep = (size_t)(BK * 2);
    const size_t hstepA = (size_t)HALF * g.lda * 2, hstepB = (size_t)HALF * g.ldb * 2;
    const size_t tstepA = 2 * hstepA, tstepB = 2 * hstepB;
    const unsigned ldsw = (unsigned)wid * 1024u;
    const int aoff = lds_byte(wr * 64 + fr, fq * 8), boff = lds_byte(wc * 32 + fr, fq * 8);
#define PG8_SA(b, h) (((b) * 2 + (h)) * HTB)
#define PG8_SB(b, h) ((4 + (b) * 2 + (h)) * HTB)
#define PG8_STAGE(bufoff, gbase, voff) do { _Pragma("unroll") for (int _i = 0; _i < 2; ++_i) \
        __builtin_amdgcn_global_load_lds((const unsigned*)((const char*)(gbase) + (voff)[_i]), (LAS unsigned*)(lds + (bufoff) + ldsw + _i * 8192), 16, 0, 0); } while (0)
#define PG8_LDA(dst, b, h) do { _Pragma("unroll") for (int m = 0; m < 4; ++m) _Pragma("unroll") for (int k = 0; k < 2; ++k) dst[m][k] = *(const LAS h16x8*)(lds + PG8_SA(b, h) + aoff + m * 2048 + k * 1024); } while (0)
#define PG8_LDB(dst, b, h) do { _Pragma("unroll") for (int n = 0; n < 2; ++n) _Pragma("unroll") for (int k = 0; k < 2; ++k) dst[n][k] = *(const LAS h16x8*)(lds + PG8_SB(b, h) + boff + n * 2048 + k * 1024); } while (0)
#define PG8_MMA(ai, bj, At, Bt) do { __builtin_amdgcn_s_setprio(1); _Pragma("unroll") for (int m = 0; m < 4; ++m) _Pragma("unroll") for (int n = 0; n < 2; ++n) _Pragma("unroll") for (int k = 0; k < 2; ++k) \
        acc[ai][bj][m][n] = __builtin_amdgcn_mfma_f32_16x16x32_f16(Bt[n][k], At[m][k], acc[ai][bj][m][n], 0, 0, 0); __builtin_amdgcn_s_setprio(0); } while (0)
#define PG8_WAIT_V(n) asm volatile("s_waitcnt vmcnt(" #n ")" ::: "memory")
#define PG8_WAIT_L(n) asm volatile("s_waitcnt lgkmcnt(" #n ")" ::: "memory")
#define PG8_BAR __builtin_amdgcn_s_barrier()
#define PG8_SCHED __builtin_amdgcn_sched_barrier(0)
    Unit cur, nxt; int ui = 0;
    if (!S.next(0, cur)) return;
    f32x4 acc[2][2][4][2];
#pragma unroll
    for (int a = 0; a < 2; ++a)
#pragma unroll
        for (int b = 0; b < 2; ++b)
#pragma unroll
            for (int m = 0; m < 4; ++m)
#pragma unroll
                for (int n = 0; n < 2; ++n) acc[a][b][m][n] = (f32x4){0.f, 0.f, 0.f, 0.f};
    h16x8 At[4][2], B0[2][2], B1[2][2];
    const char* cA = (const char*)g.A + (size_t)cur.pm * tstepA; const char* cB = (const char*)g.Bt + (size_t)cur.pn * tstepB;
    PG8_STAGE(PG8_SB(0, 0), cB, voffB); PG8_STAGE(PG8_SB(0, 1), cB + hstepB, voffB); PG8_STAGE(PG8_SA(0, 0), cA, voffA); PG8_STAGE(PG8_SA(0, 1), cA + hstepA, voffA);
    if (wr == 1) PG8_BAR;
    PG8_WAIT_V(2); PG8_BAR;
    PG8_STAGE(PG8_SB(1, 0), cB + kstep, voffB); PG8_STAGE(PG8_SA(1, 0), cA + kstep, voffA); PG8_STAGE(PG8_SB(1, 1), cB + hstepB + kstep, voffB);
    PG8_WAIT_V(6); PG8_BAR;
    for (;;) {
        const bool has_next = S.next(ui + 1, nxt);
        const char* nA = has_next ? (const char*)g.A + (size_t)nxt.pm * tstepA : cA; const char* nB = has_next ? (const char*)g.Bt + (size_t)nxt.pn * tstepB : cB;
        for (int t = 0; t < nt; t += 2) {
            const bool last = (t == nt - 2);
            const char* a1 = cA + (size_t)(t + 1) * kstep;
            const char* a2 = last ? nA : cA + (size_t)(t + 2) * kstep; const char* b2 = last ? nB : cB + (size_t)(t + 2) * kstep;
            const char* a3 = a2 + kstep; const char* b3 = b2 + kstep;
            E.mid(acc, cur, t, wr, wc, fr, fq);
            PG8_LDB(B0, 0, 0); PG8_LDB(B1, 0, 1); PG8_SCHED; PG8_LDA(At, 0, 0); PG8_STAGE(PG8_SA(1, 1), a1 + hstepA, voffA);
            PG8_WAIT_V(8); PG8_WAIT_L(0); PG8_BAR; PG8_MMA(0, 0, At, B0); PG8_MMA(0, 1, At, B1); PG8_BAR; PG8_SCHED;
            PG8_LDA(At, 0, 1); PG8_STAGE(PG8_SB(0, 0), b2, voffB); PG8_STAGE(PG8_SB(0, 1), b2 + hstepB, voffB); PG8_STAGE(PG8_SA(0, 0), a2, voffA);
            PG8_WAIT_V(8); PG8_WAIT_L(0); PG8_BAR; PG8_MMA(1, 0, At, B0); PG8_MMA(1, 1, At, B1); PG8_BAR; PG8_SCHED;
            PG8_LDB(B0, 1, 0); PG8_LDB(B1, 1, 1); PG8_SCHED; PG8_LDA(At, 1, 0); PG8_STAGE(PG8_SA(0, 1), a2 + hstepA, voffA);
            PG8_WAIT_V(8); PG8_WAIT_L(0); PG8_BAR; PG8_MMA(0, 0, At, B0); PG8_MMA(0, 1, At, B1); PG8_BAR; PG8_SCHED;
            PG8_LDA(At, 1, 1); PG8_STAGE(PG8_SB(1, 0), b3, voffB); PG8_STAGE(PG8_SB(1, 1), b3 + hstepB, voffB); PG8_STAGE(PG8_SA(1, 0), a3, voffA);
            PG8_WAIT_V(8); PG8_WAIT_L(0); PG8_BAR; PG8_MMA(1, 0, At, B0); PG8_MMA(1, 1, At, B1); PG8_BAR; PG8_SCHED;
        }
        if (wr == 0) PG8_BAR;
        E(acc, cur, wr, wc, fr, fq);
        if (!has_next) break;
#pragma unroll
        for (int a = 0; a < 2; ++a)
#pragma unroll
            for (int b = 0; b < 2; ++b)
#pragma unroll
                for (int m = 0; m < 4; ++m)
#pragma unroll
                    for (int n = 0; n < 2; ++n) acc[a][b][m][n] = (f32x4){0.f, 0.f, 0.f, 0.f};
        cur = nxt; cA = nA; cB = nB; ++ui;
        if (wr == 1) PG8_BAR;
    }
    PG8_WAIT_V(0);
    PG8_BAR;
#undef PG8_SA
#undef PG8_SB
#undef PG8_STAGE
#undef PG8_LDA
#undef PG8_LDB
#undef PG8_MMA
#undef PG8_WAIT_V
#undef PG8_WAIT_L
#undef PG8_BAR
#undef PG8_SCHED
}

typedef f32x4 Acc[2][2][4][2];
struct EpiBase { __device__ __forceinline__ void mid(Acc&, const Unit&, int, int, int, int, int) const {} };
struct EpiSwiglu : EpiBase {
    static constexpr bool PERM = true;
    half_t* H; int ldh;
    __device__ __forceinline__ void operator()(const Acc& acc, const Unit& u, int wr, int wc, int fr, int fq) const {
        const int row0 = u.pm * BM + wr * 64 + fr, col0 = u.pn * 128 + wc * 32 + 8 * fq;
#pragma unroll
        for (int ai = 0; ai < 2; ++ai)
#pragma unroll
            for (int m = 0; m < 4; ++m) {
                half_t* rowp = H + (size_t)(row0 + ai * HALF + m * 16) * ldh + col0;
                float o[8];
#pragma unroll
                for (int n = 0; n < 2; ++n)
#pragma unroll
                    for (int j = 0; j < 4; ++j) { const float gt = acc[ai][0][m][n][j], up = acc[ai][1][m][n][j]; o[n * 4 + j] = gt * fast_sigmoid(gt) * up; }
                u32x4 w; w.x = pkh(o[0], o[1]); w.y = pkh(o[2], o[3]); w.z = pkh(o[4], o[5]); w.w = pkh(o[6], o[7]);
                *(u32x4*)rowp = w;
            }
    }
};
struct EpiResid16 : EpiBase {
    static constexpr bool PERM = true;
    const half_t* X; half_t* O; float alpha, coef;
    __device__ __forceinline__ void operator()(const Acc& acc, const Unit& u, int wr, int wc, int fr, int fq) const {
        const int row0 = u.pm * BM + wr * 64 + fr, col0 = u.pn * BM + wc * 32 + 8 * fq;
        h16x8 xv[2][2];
#pragma unroll
        for (int bj = 0; bj < 2; ++bj) xv[0][bj] = *(const h16x8*)(X + (size_t)row0 * D + col0 + bj * HALF);
#pragma unroll
        for (int i = 0; i < 8; ++i) { const int ai = i >> 2, m = i & 3; const size_t off = (size_t)(row0 + ai * HALF + m * 16) * D + col0;
            if (i + 1 < 8) { const size_t offn = (size_t)(row0 + ((i + 1) >> 2) * HALF + ((i + 1) & 3) * 16) * D + col0;
#pragma unroll
                for (int bj = 0; bj < 2; ++bj) xv[(i + 1) & 1][bj] = *(const h16x8*)(X + offn + bj * HALF); }
#pragma unroll
            for (int bj = 0; bj < 2; ++bj) { const h16x8 x = xv[i & 1][bj]; const f32x4 a0 = acc[ai][bj][m][0], a1 = acc[ai][bj][m][1];
                u32x4 w; w.x = pkh((float)x[0] * alpha + a0[0] * coef, (float)x[1] * alpha + a0[1] * coef); w.y = pkh((float)x[2] * alpha + a0[2] * coef, (float)x[3] * alpha + a0[3] * coef);
                w.z = pkh((float)x[4] * alpha + a1[0] * coef, (float)x[5] * alpha + a1[1] * coef); w.w = pkh((float)x[6] * alpha + a1[2] * coef, (float)x[7] * alpha + a1[3] * coef);
                *(u32x4*)(O + off + bj * HALF) = w; }
            asm volatile("" ::: "memory"); }
    }
};
struct EpiH16 : EpiBase {
    static constexpr bool PERM = true;
    half_t* O; int ldc; int sig_from;
    __device__ __forceinline__ void operator()(const Acc& acc, const Unit& u, int wr, int wc, int fr, int fq) const {
        const int row0 = u.pm * BM + wr * 64 + fr, col0 = u.pn * BM + wc * 32 + 8 * fq;
        const bool sg = u.pn >= sig_from;
#pragma unroll
        for (int ai = 0; ai < 2; ++ai)
#pragma unroll
            for (int m = 0; m < 4; ++m) { half_t* rowp = O + (size_t)(row0 + ai * HALF + m * 16) * ldc + col0;
#pragma unroll
                for (int bj = 0; bj < 2; ++bj) { f32x4 v0 = acc[ai][bj][m][0], v1 = acc[ai][bj][m][1];
                    if (sg) {
#pragma unroll
                        for (int j = 0; j < 4; ++j) { v0[j] = fast_sigmoid(v0[j]); v1[j] = fast_sigmoid(v1[j]); } }
                    u32x4 w; w.x = pkh(v0[0], v0[1]); w.y = pkh(v0[2], v0[3]); w.z = pkh(v1[0], v1[1]); w.w = pkh(v1[2], v1[3]);
                    *(u32x4*)(rowp + bj * HALF) = w; } }
    }
};
template <int MODE> struct EpiBranch : EpiBase {
    static constexpr bool PERM = false;
    const half_t* G; int ldg; float* T; half_t* O;
    __device__ __forceinline__ void operator()(const Acc& acc, const Unit& u, int wr, int wc, int fr, int fq) const {
        const int row0 = u.pm * BM + wr * 64 + fr, col0 = u.pn * BM + wc * 32 + 4 * fq;
#pragma unroll
        for (int ai = 0; ai < 2; ++ai)
#pragma unroll
            for (int m = 0; m < 4; ++m) { const int row = row0 + ai * HALF + m * 16; const size_t off = (size_t)row * D + col0;
#pragma unroll
                for (int bj = 0; bj < 2; ++bj)
#pragma unroll
                    for (int n = 0; n < 2; ++n) { const int co = bj * HALF + n * 16;
                        const h16x4 gv = *(const h16x4*)(G + (size_t)row * ldg + col0 + co);
                        f32x4 v = acc[ai][bj][m][n]; v[0] *= (float)gv[0]; v[1] *= (float)gv[1]; v[2] *= (float)gv[2]; v[3] *= (float)gv[3];
                        if (MODE >= 1) v += *(const f32x4*)(T + off + co);
                        if (MODE <= 1) *(f32x4*)(T + off + co) = v;
                        else { u32x2 w; w.x = pkh(v[0], v[1]); w.y = pkh(v[2], v[3]); *(u32x2*)(O + off + co) = w; } }
                asm volatile("" ::: "memory"); }
    }
};
struct EpiGate {
    static constexpr bool PERM = false;
    const half_t* G; int ldg; half_t* O; int t1, t2;
    __device__ __forceinline__ static float gfl(half_t g) { return fmaxf((float)g, 5.9604645e-8f); }
    __device__ __forceinline__ void mid(Acc& acc, const Unit& u, int t, int wr, int wc, int fr, int fq) const {
        if (t != t1 && t != t2) return;
        const half_t* Gn = G + (t == t1 ? 0 : D);
        int row0 = u.pm * BM + wr * 64 + fr, col0 = u.pn * BM + wc * 32 + 4 * fq;
        asm volatile("" : "+v"(row0), "+v"(col0));
#pragma unroll
        for (int i2 = 0; i2 < 4; ++i2) {
            const int ai = i2 >> 1, mb = (i2 & 1) * 2;
            h16x4 gn[2][4], gd[2][4];
#pragma unroll
            for (int mm = 0; mm < 2; ++mm) { const half_t* gp = Gn + (size_t)(row0 + ai * HALF + (mb + mm) * 16) * ldg + col0;
#pragma unroll
                for (int bj = 0; bj < 2; ++bj)
#pragma unroll
                    for (int n = 0; n < 2; ++n) { gn[mm][bj * 2 + n] = *(const h16x4*)(gp + bj * HALF + n * 16); gd[mm][bj * 2 + n] = *(const h16x4*)(gp + D + bj * HALF + n * 16); } }
#pragma unroll
            for (int mm = 0; mm < 2; ++mm)
#pragma unroll
                for (int bj = 0; bj < 2; ++bj)
#pragma unroll
                    for (int n = 0; n < 2; ++n)
#pragma unroll
                        for (int e = 0; e < 4; ++e) acc[ai][bj][mb + mm][n][e] *= gfl(gn[mm][bj * 2 + n][e]) * __builtin_amdgcn_rcpf(gfl(gd[mm][bj * 2 + n][e]));
            asm volatile("" ::: "memory");
        }
    }
    __device__ __forceinline__ void operator()(const Acc& acc, const Unit& u, int wr, int wc, int fr, int fq) const {
        const int row0 = u.pm * BM + wr * 64 + fr, col0 = u.pn * BM + wc * 32 + 4 * fq;
#pragma unroll
        for (int ai = 0; ai < 2; ++ai)
#pragma unroll
            for (int m = 0; m < 4; ++m) { const int row = row0 + ai * HALF + m * 16; const half_t* gp = G + 2 * D + (size_t)row * ldg + col0;
#pragma unroll
                for (int bj = 0; bj < 2; ++bj)
#pragma unroll
                    for (int n = 0; n < 2; ++n) { const int co = bj * HALF + n * 16; const h16x4 gv = *(const h16x4*)(gp + co); const f32x4 v = acc[ai][bj][m][n];
                        u32x2 w; w.x = pkh(v[0] * gfl(gv[0]), v[1] * gfl(gv[1])); w.y = pkh(v[2] * gfl(gv[2]), v[3] * gfl(gv[3])); *(u32x2*)(O + (size_t)row * D + col0 + co) = w; } }
    }
};
}

enum { PX_X16 = 0, PX_R1, PX_PRELN, PX_OCAT, PX_QB, PX_KVB, PX_LATN, PX_KROPE, PX_TMPF, PX_SEL, PX_CS, PX_MEMKV, PX_LUT, PX_SELM, PX_MEM16, PX_WMEM, PX_GSUM, PX_N };
enum { LWX_UP1 = 0, LWX_DN1, LWX_IN, LWX_UQ, LWX_UKV, LWX_BR, LWX_OUT, LWX_UP2, LWX_DN2, LWX_N };
struct Args { const void* in[18]; float* out; unsigned char* ws; unsigned char* p[PX_N]; unsigned char* lw[DEPTH][LWX_N]; int ph_lo, ph_hi; };
struct Frame {
    LAS unsigned char* lds;
    int tid, lane, wave, G, gw, NGW;
    unsigned char* ws;
};

__device__ __forceinline__ Frame make_frame(int wave) {
    extern __shared__ __attribute__((aligned(16))) unsigned char lds_raw[];
    Frame F; F.lds = (LAS unsigned char*)lds_raw; F.wave = __builtin_amdgcn_readfirstlane(wave); asm volatile("" : "+s"(F.wave)); F.lane = lane_id(); F.tid = F.wave * 64 + F.lane;
    F.G = gridDim.x; F.gw = blockIdx.x * NWAVES + F.wave; F.NGW = F.G * NWAVES; F.ws = nullptr; return F;
}
typedef const struct Args __attribute__((address_space(4))) CArgs;
__device__ __forceinline__ int map_col(int kind, int n, float& scale) {
    scale = 1.f;
    if (kind == 0) return n;
    if (kind == 1) { if (n < DFF) return 256 * (n >> 7) + (n & 127); const int q = n - DFF; return 256 * (q >> 7) + 128 + (q & 127); }
    if (n < 2112) return n;
    if (n < 2128) { scale = 1.0f / 32.0f; return n + 64; }
    if (n < 3152) return n + 176;
    if (n < 3216) return n - 1040;
    return n + 112;
}
__device__ __forceinline__ void transpose_item(const float* W, int K, int N, half_t* WT, int kind, LAS float* scr, int item, int lane) {
    const int nblk = (N + 31) / 32, kb = item / nblk, nb = item % nblk, k0 = 64 * kb, n0 = 32 * nb;
    const int nl = (n0 + (lane & 31) < N) ? n0 + (lane & 31) : N - 1;
#pragma unroll 8
    for (int i = 0; i < 32; ++i) { const int kk = 2 * i + (lane >> 5); scr[kk * 33 + (lane & 31)] = W[(size_t)(k0 + kk) * N + nl]; }
    LDS_WAIT(); asm volatile("" ::: "memory");
    const int c = lane & 7;
#pragma unroll
    for (int j = 0; j < 4; ++j) { const int nn = (lane >> 3) + 8 * j; const int n = n0 + nn;
        if (n < N) { float sc; const int dr = map_col(kind, n, sc); const LAS float* s = scr + (8 * c) * 33 + nn;
            u32x4 o; o.x = pkh(s[0 * 33] * sc, s[1 * 33] * sc); o.y = pkh(s[2 * 33] * sc, s[3 * 33] * sc); o.z = pkh(s[4 * 33] * sc, s[5 * 33] * sc); o.w = pkh(s[6 * 33] * sc, s[7 * 33] * sc);
            *(u32x4*)(WT + (size_t)dr * K + k0 + 8 * c) = o; } }
    LDS_WAIT(); asm volatile("" ::: "memory");
}
__device__ __forceinline__ void cvt_f32_to_h16(const float* src, half_t* dst, size_t n8, size_t i0, size_t stride) {
    for (size_t i = i0; i < n8; i += stride) { const f32x4 a = *(const f32x4*)(src + i * 8), b = *(const f32x4*)(src + i * 8 + 4);
        u32x4 o; o.x = pkh(a[0], a[1]); o.y = pkh(a[2], a[3]); o.z = pkh(b[0], b[1]); o.w = pkh(b[2], b[3]); *(u32x4*)(dst + i * 8) = o; }
}

__device__ __forceinline__ void sincos_f32arg(float ang, float& c, float& s) {
    const double x = (double)ang; const double k = __builtin_rint(x * 0.15915494309189535); const double r = x - k * 6.283185307179586; const double r2 = r * r;
    double ts = r, sn = r, tc = 1.0, cn = 1.0;
#pragma unroll 1
    for (int i = 1; i <= 14; ++i) { ts *= -r2 / (double)((2 * i) * (2 * i + 1)); sn += ts; tc *= -r2 / (double)((2 * i - 1) * (2 * i)); cn += tc; }
    c = (float)cn; s = (float)sn;
}
#define PRO_JOB(Wp, Kv, Nv, WTp, kindv) do { const float* _W = (Wp); half_t* _WT = (WTp); const int _nitems = ((Kv) / 64) * (((Nv) + 31) / 32); \
    for (int it = F.gw; it < _nitems; it += F.NGW) transpose_item(_W, (Kv), (Nv), _WT, (kindv), scr, it, F.lane); } while (0)
__device__ __forceinline__ void phase_prologue(const Frame& F0, const Args __attribute__((address_space(4)))* argsp) {
    Frame F = F0; asm volatile("" : "+v"(F.lane)); asm volatile("" : "+s"(F.gw));
#define args (*argsp)
    LAS float* scr = (LAS float*)(F.lds + F.wave * 16384);
    unsigned char* ws = F.ws;
#pragma unroll 1
    for (int l = 0; l < DEPTH; ++l) {
        unsigned char* lw = ws + WS_W + (size_t)l * LW_END;
        PRO_JOB((const float*)args.in[6] + (size_t)l * D * 2 * DFF, D, 2 * DFF, (half_t*)(lw + LW_UP1), 1);
        PRO_JOB((const float*)args.in[7] + (size_t)l * DFF * D, DFF, D, (half_t*)(lw + LW_DN1), 0);
        PRO_JOB((const float*)args.in[8] + (size_t)l * D * IN_COLS, D, IN_COLS, (half_t*)(lw + LW_IN), 2);
        PRO_JOB((const float*)args.in[11] + (size_t)l * QL * 1152, QL, 1152, (half_t*)(lw + LW_UQ), 0);
        PRO_JOB((const float*)args.in[12] + (size_t)l * KVL * 1536, KVL, 1536, (half_t*)(lw + LW_UKV), 0);
        PRO_JOB((const float*)args.in[14] + (size_t)l * D * D, D, D, (half_t*)(lw + LW_BR), 0);
        PRO_JOB((const float*)args.in[15] + (size_t)l * D * D, D, D, (half_t*)(lw + LW_OUT), 0);
        PRO_JOB((const float*)args.in[16] + (size_t)l * D * 2 * DFF, D, 2 * DFF, (half_t*)(lw + LW_UP2), 1);
        PRO_JOB((const float*)args.in[17] + (size_t)l * DFF * D, DFF, D, (half_t*)(lw + LW_DN2), 0);
        PRO_JOB((const float*)args.in[13] + (size_t)l * D * 1024, D, 1024, (half_t*)(ws + WS_WMEM) + (size_t)l * 1024 * D, 0);
        { u32x4 z = {0u, 0u, 0u, 0u}; const size_t gt = (size_t)F.gw * 64 + F.lane, gs = (size_t)F.NGW * 64;
          u32x4* p1 = (u32x4*)((half_t*)(lw + LW_IN) + (size_t)2192 * D); for (size_t i = gt; i < (size_t)112 * D / 8; i += gs) p1[i] = z;
          u32x4* p2 = (u32x4*)((half_t*)(lw + LW_UQ) + (size_t)1152 * QL); for (size_t i = gt; i < (size_t)128 * QL / 8; i += gs) p2[i] = z; }
    }
    const size_t gt = (size_t)F.gw * 64 + F.lane, gs = (size_t)F.NGW * 64;
    cvt_f32_to_h16((const float*)args.in[0], (half_t*)(ws + WS_X16), (size_t)M * D / 8, gt, gs);
    cvt_f32_to_h16((const float*)args.in[1], (half_t*)(ws + WS_MEM16), (size_t)BATCH * MEML * D / 8, gt, gs);
    { const int* pos = (const int*)args.in[2]; float* cs = (float*)(ws + WS_CS);
      for (size_t i = gt; i < (size_t)M * 32; i += gs) { const int m = (int)(i >> 5), f = (int)(i & 31);
          double v = 1.0; for (int q = 0; q < f; ++q) v *= 0.7498942093324559;
          const float inv_freq = (float)v; const float ang = (float)pos[m] * inv_freq; float c, s; sincos_f32arg(ang, c, s);
          cs[(size_t)m * 64 + f] = c; cs[(size_t)m * 64 + 32 + f] = s; } }
    if (F.gw == 0) { int* lut = (int*)(ws + WS_LUT);
#undef args
        for (int n = F.lane; n <= 128; n += 64) { int bkt; if (n < 16) bkt = n; else { const float lg2 = __builtin_amdgcn_logf((float)n * (1.0f / 16.0f)); int lg = 16 + (int)(lg2 * (16.0f / 3.0f)); bkt = lg < 31 ? lg : 31; } lut[n] = bkt; } }
}

__device__ __forceinline__ void phase_ln(const Frame& F0, const half_t* pre, const float* g, const float* b, half_t* x16, float* fout) {
    Frame F = F0; asm volatile("" : "+v"(F.lane)); asm volatile("" : "+s"(F.gw));
    for (int m = F.gw; m < M; m += F.NGW) {
        const h16x8* xr = (const h16x8*)(pre + (size_t)m * D) + F.lane;
        float v[4][8]; float s = 0.f;
#pragma unroll
        for (int j = 0; j < 4; ++j) { const h16x8 t = xr[64 * j];
#pragma unroll
            for (int e = 0; e < 8; ++e) { v[j][e] = (float)t[e]; s += v[j][e]; } }
        const float mean = wave_sum(s) * (1.f / D); float s2 = 0.f;
#pragma unroll
        for (int j = 0; j < 4; ++j)
#pragma unroll
            for (int e = 0; e < 8; ++e) { v[j][e] -= mean; s2 += v[j][e] * v[j][e]; }
        const float rstd = 1.0f / sqrtf(wave_sum(s2) * (1.f / D) + LN_EPS);
#pragma unroll
        for (int j = 0; j < 4; ++j) { const int c = 8 * (F.lane + 64 * j);
            const f32x4 g0 = *(const f32x4*)(g + c), g1 = *(const f32x4*)(g + c + 4), b0 = *(const f32x4*)(b + c), b1 = *(const f32x4*)(b + c + 4);
            f32x4 o0, o1;
#pragma unroll
            for (int e = 0; e < 4; ++e) { o0[e] = v[j][e] * rstd * g0[e] + b0[e]; o1[e] = v[j][4 + e] * rstd * g1[e] + b1[e]; }
            u32x4 w; w.x = pkh(o0[0], o0[1]); w.y = pkh(o0[2], o0[3]); w.z = pkh(o1[0], o1[1]); w.w = pkh(o1[2], o1[3]);
            *(u32x4*)(x16 + (size_t)m * D + c) = w;
            if (fout) { *(f32x4*)(fout + (size_t)m * D + c) = o0; *(f32x4*)(fout + (size_t)m * D + c + 4) = o1; } }
    }
}

__device__ __forceinline__ unsigned sortable(float f) { f = f + 0.0f; unsigned u = __builtin_bit_cast(unsigned, f); return (u & 0x80000000u) ? ~u : (u | 0x80000000u); }
__device__ __forceinline__ void phase_p5(const Frame& F0, const half_t* proj, const float* qn, const float* kvn, half_t* latn, half_t* krope, const float* cs, unsigned short* sel) {
    Frame F = F0; asm volatile("" : "+v"(F.lane)); asm volatile("" : "+s"(F.gw));
    for (int m = F.gw; m < M; m += F.NGW) {
        const half_t* pr = proj + (size_t)m * PROJ_LD;
#pragma unroll
        for (int w = 0; w < 2; ++w) {
            const h16x8 v = *(const h16x8*)(pr + (w ? PC_CKVL : PC_CQL) + 8 * F.lane);
            float f[8], s = 0.f;
#pragma unroll
            for (int j = 0; j < 8; ++j) { f[j] = (float)v[j]; s += f[j] * f[j]; }
            const float r = 1.0f / sqrtf(wave_sum(s) * (1.f / 512.f) + RMS_EPS);
            const float* gp = (w ? kvn : qn) + 8 * F.lane;
            u32x4 o; o.x = pkh(f[0] * r * gp[0], f[1] * r * gp[1]); o.y = pkh(f[2] * r * gp[2], f[3] * r * gp[3]); o.z = pkh(f[4] * r * gp[4], f[5] * r * gp[5]); o.w = pkh(f[6] * r * gp[6], f[7] * r * gp[7]);
            *(u32x4*)(latn + (size_t)m * LATN_LD + w * 512 + 8 * F.lane) = o;
        }
        if (F.lane < 32) { const float x1 = (float)pr[PC_KR + F.lane], x2 = (float)pr[PC_KR + 32 + F.lane]; const float c = cs[(size_t)m * 64 + F.lane], s = cs[(size_t)m * 64 + 32 + F.lane];
            krope[(size_t)m * ROPE + F.lane] = (half_t)(x1 * c - x2 * s); krope[(size_t)m * ROPE + 32 + F.lane] = (half_t)(x1 * s + x2 * c); }
    }
}
__device__ __forceinline__ void topk_select(const float (&sc)[32], int nk, int lane_, unsigned short* so, unsigned long long* sm) {
    int lane = lane_; asm volatile("" : "+v"(lane));
    unsigned u[32];
#pragma unroll
    for (int j = 0; j < 32; ++j) { const int s = 64 * j + lane; u[j] = (s < nk) ? sortable(sc[j]) : 0u; }
    const int nblk = (nk + 511) >> 9;
    unsigned prefix = 0u;
#pragma unroll 1
    for (int bit = 31; bit >= 0; --bit) { const unsigned cand = prefix | (1u << bit); int cnt = 0;
#pragma unroll
        for (int bq = 0; bq < 4; ++bq) if (bq < nblk) {
#pragma unroll
            for (int j = 8 * bq; j < 8 * bq + 8; ++j) cnt += __popcll(__ballot(u[j] >= cand)); }
        if (cnt >= TOPK) { prefix = cand; if (cnt == TOPK) break; } }
    int cgt = 0;
#pragma unroll
    for (int bq = 0; bq < 4; ++bq) if (bq < nblk) {
#pragma unroll
        for (int j = 8 * bq; j < 8 * bq + 8; ++j) cgt += __popcll(__ballot(u[j] > prefix)); }
    int need = TOPK - cgt;
    int pos = 0;
    const unsigned long long lt_mask = (1ull << lane) - 1ull;
#pragma unroll
    for (int j = 0; j < 32; ++j) {
        const unsigned long long beq = __ballot(u[j] == prefix);
        const int rank_eq = __popcll(beq & lt_mask);
        const bool pick = (u[j] > prefix) || (u[j] == prefix && rank_eq < need);
        const unsigned long long bp = __ballot(pick);
        if (pick) so[pos + __popcll(bp & lt_mask)] = (unsigned short)(64 * j + lane);
        if (lane == 0) sm[j] = bp;
        pos += __popcll(bp);
        const int neq = __popcll(beq); need = need > neq ? need - neq : 0;
    }
}
__device__ __forceinline__ void phase_indexer(const Frame& F0, const half_t* proj, unsigned short* sel, unsigned long long* selm) {
    Frame F = F0; asm volatile("" : "+v"(F.lane)); asm volatile("" : "+v"(F.tid)); asm volatile("" : "+s"(F.wave));
    const int lane = F.lane, tid = F.tid, wave = F.wave, g4 = lane >> 4, l15 = lane & 15, hi = lane >> 5, mid = (lane >> 4) & 1;
    LAS unsigned char* lds = F.lds;
    constexpr int CHB = 256 * 128;
    const int srow = tid >> 1, spc = (tid & 1) * 4;
    int bid = blockIdx.x; asm volatile("" : "+s"(bid));
#pragma unroll 1
    for (int gi = bid; gi < BATCH * 128; gi += F.G) {
        const int b = gi >> 7, rr = gi & 127, tg = ((gi >> 8) & 1) ? 127 - rr : rr;
        const int t0 = 16 * tg;
        if (t0 < TOPK) {
#pragma unroll 1
            for (int tk = 0; tk < 2; ++tk) { const int t = t0 + 8 * tk + wave, m = b * SEQ + t, nk = t + 1;
                unsigned short* so = sel + (size_t)m * TOPK; unsigned long long* sm = selm + (size_t)m * 32;
                for (int j = lane; j < TOPK; j += 64) so[j] = (unsigned short)(j < nk ? j : 0);
                if (lane < 32) { const int lo_ = 64 * lane; sm[lane] = (nk >= lo_ + 64) ? ~0ull : (nk > lo_ ? ((1ull << (nk - lo_)) - 1ull) : 0ull); } }
            continue;
        }
        const int tA = t0 + wave, tB = t0 + 8 + wave;
        const half_t* prA = proj + (size_t)(b * SEQ + tA) * PROJ_LD; const half_t* prB = proj + (size_t)(b * SEQ + tB) * PROJ_LD;
        h16x8 afA[2], afB[2]; float wA[4], wB[4];
#pragma unroll
        for (int ks = 0; ks < 2; ++ks) { afA[ks] = *(const h16x8*)(prA + PC_IQ + l15 * 64 + 32 * ks + 8 * g4); afB[ks] = *(const h16x8*)(prB + PC_IQ + l15 * 64 + 32 * ks + 8 * g4); }
#pragma unroll
        for (int r = 0; r < 4; ++r) { wA[r] = (float)prA[PC_IW + 4 * g4 + r]; wB[r] = (float)prB[PC_IW + 4 * g4 + r]; }
        float scA[32], scB[32];
#pragma unroll
        for (int j = 0; j < 32; ++j) { scA[j] = 0.f; scB[j] = 0.f; }
        const int nch = (t0 + 15) / 256 + 1;
        u32x4 kreg[4];
        const half_t* kbase = proj + (size_t)(b * SEQ + srow) * PROJ_LD + PC_IK + 8 * spc;
#define IDX_ISSUE(ch) do { const half_t* kp = kbase + (size_t)(ch) * 256 * PROJ_LD; _Pragma("unroll") for (int k = 0; k < 4; ++k) kreg[k] = *(const u32x4*)(kp + 8 * k); } while (0)
#define IDX_WRITE(buf) do { _Pragma("unroll") for (int k = 0; k < 4; ++k) *(LAS u32x4*)(lds + (buf) * CHB + srow * 128 + (((spc + k) ^ ((srow >> 1) & 7)) << 4)) = kreg[k]; } while (0)
        __syncthreads();
        IDX_ISSUE(0); IDX_WRITE(0);
        __syncthreads();
#pragma unroll
        for (int g = 0; g < 8; ++g) {
            if (g < nch) {
                if (g + 1 < nch) IDX_ISSUE(g + 1);
                LAS unsigned char* cb = lds + (g & 1) * CHB;
#pragma unroll
                for (int q = 0; q < 4; ++q) {
                    float pA[4], pB[4];
#pragma unroll
                    for (int k4 = 0; k4 < 4; ++k4) {
                        const int row = 16 * (4 * q + k4) + l15; const int sw = (row >> 1) & 7;
                        const h16x8 b0 = *(const LAS h16x8*)(cb + row * 128 + ((g4 ^ sw) << 4)), b1 = *(const LAS h16x8*)(cb + row * 128 + (((g4 + 4) ^ sw) << 4));
                        f32x4 dA = {0.f, 0.f, 0.f, 0.f}, dB = {0.f, 0.f, 0.f, 0.f};
                        dA = __builtin_amdgcn_mfma_f32_16x16x32_f16(afA[0], b0, dA, 0, 0, 0); dB = __builtin_amdgcn_mfma_f32_16x16x32_f16(afB[0], b0, dB, 0, 0, 0);
                        dA = __builtin_amdgcn_mfma_f32_16x16x32_f16(afA[1], b1, dA, 0, 0, 0); dB = __builtin_amdgcn_mfma_f32_16x16x32_f16(afB[1], b1, dB, 0, 0, 0);
                        pA[k4] = (wA[0] * fmaxf(dA[0], 0.f) + wA[1] * fmaxf(dA[1], 0.f)) + (wA[2] * fmaxf(dA[2], 0.f) + wA[3] * fmaxf(dA[3], 0.f));
                        pB[k4] = (wB[0] * fmaxf(dB[0], 0.f) + wB[1] * fmaxf(dB[1], 0.f)) + (wB[2] * fmaxf(dB[2], 0.f) + wB[3] * fmaxf(dB[3], 0.f));
                    }
                    { const float sendA = hi ? pA[0] : pA[2], sendB = hi ? pA[1] : pA[3];
                      const float keepA = (hi ? pA[2] : pA[0]) + xshfl_f(sendA, 32, lane), keepB = (hi ? pA[3] : pA[1]) + xshfl_f(sendB, 32, lane);
                      const float send = mid ? keepA : keepB; scA[4 * g + q] = (mid ? keepB : keepA) + xshfl_f(send, 16, lane); }
                    { const float sendA = hi ? pB[0] : pB[2], sendB = hi ? pB[1] : pB[3];
                      const float keepA = (hi ? pB[2] : pB[0]) + xshfl_f(sendA, 32, lane), keepB = (hi ? pB[3] : pB[1]) + xshfl_f(sendB, 32, lane);
                      const float send = mid ? keepA : keepB; scB[4 * g + q] = (mid ? keepB : keepA) + xshfl_f(send, 16, lane); }
                }
                if (g + 1 < nch) IDX_WRITE((g + 1) & 1);
                __syncthreads();
            }
        }
#undef IDX_ISSUE
#undef IDX_WRITE
        { int mA = b * SEQ + tA; asm volatile("" : "+s"(mA));
          topk_select(scA, tA + 1, lane, sel + (size_t)mA * TOPK, selm + (size_t)mA * 32); }
        { int mB = b * SEQ + tB; asm volatile("" : "+s"(mB));
          topk_select(scB, tB + 1, lane, sel + (size_t)mB * TOPK, selm + (size_t)mB * 32); }
        asm volatile("" ::: "memory");
    }
    __syncthreads();
}

template <int NH, bool IS_A>
__device__ __forceinline__ void phase_gattn(const Frame& F0, const half_t* proj, const half_t* memkv, const unsigned short* sel, const int* pos, const float* relb, const int* lut, half_t* ocat) {
    Frame F = F0; asm volatile("" : "+v"(F.lane)); asm volatile("" : "+s"(F.gw));
    LAS unsigned char* wl = F.lds + F.wave * 16384;
    LAS half_t* q_l = (LAS half_t*)wl;
    LAS float* p_l = (LAS float*)(wl + 2048);
    LAS unsigned* idx_l = (LAS unsigned*)(wl + 2048 + 8192);
    LAS float* rb_l = (LAS float*)(wl + 2048 + 8192 + 1024);
    const float scale = 0.08838834764831845f;
    if (IS_A) { for (int i = F.lane; i < 32 * 8; i += 64) rb_l[i] = ((i & 7) < A_HEADS) ? relb[(i >> 3) * A_HEADS + (i & 7)] : 0.f; }
    for (int m = F.gw; m < M; m += F.NGW) {
        const int b = m / SEQ, t = m % SEQ;
        const int nk = IS_A ? (t + 1 < TOPK ? t + 1 : TOPK) : MEML;
        const half_t* qp = proj + (size_t)m * PROJ_LD + (IS_A ? PC_AQ : PC_CQ);
        for (int i = F.lane; i < NH * 16; i += 64) *(LAS u32x4*)(q_l + 8 * i) = *(const u32x4*)(qp + 8 * i);
        for (int j = F.lane; j < 256; j += 64) idx_l[j] = IS_A ? (unsigned)(b * SEQ + sel[(size_t)m * TOPK + j]) : (unsigned)(b * MEML + j);
        LDS_WAIT(); asm volatile("" ::: "memory");
        const int pq = IS_A ? pos[m] : 0;
        float lg[4][NH];
#pragma unroll
        for (int i = 0; i < 4; ++i) {
            const int j = i * 64 + F.lane; const bool valid = j < nk; const unsigned row = idx_l[valid ? j : 0];
            float bias[NH];
#pragma unroll
            for (int h = 0; h < NH; ++h) bias[h] = 0.f;
            if (IS_A) { int dist = pq - pos[row]; dist = dist < 0 ? 0 : (dist > 128 ? 128 : dist); const int bk = lut[dist];
#pragma unroll
                for (int h = 0; h < NH; ++h) bias[h] = rb_l[bk * 8 + h]; }
            if (IS_A) {
                const half_t* kp = proj + (size_t)row * PROJ_LD + PC_AK;
                float d[NH];
#pragma unroll
                for (int h = 0; h < NH; ++h) d[h] = 0.f;
#pragma unroll 4
                for (int c = 0; c < 16; ++c) { const h16x8 kv = *(const h16x8*)(kp + 8 * c);
#pragma unroll
                    for (int h = 0; h < NH; ++h) { const h16x8 qv = *(const LAS h16x8*)(q_l + h * 128 + 8 * c);
#pragma unroll
                        for (int e = 0; e < 4; ++e) { h16x2 qa, ka; qa.x = qv[2 * e]; qa.y = qv[2 * e + 1]; ka.x = kv[2 * e]; ka.y = kv[2 * e + 1]; d[h] = __builtin_amdgcn_fdot2(qa, ka, d[h], false); } } }
#pragma unroll
                for (int h = 0; h < NH; ++h) lg[i][h] = valid ? d[h] * scale + bias[h] : -INFINITY;
            } else {
#pragma unroll
                for (int h = 0; h < NH; ++h) { const half_t* kp = memkv + (size_t)row * 4096 + h * 128; float d = 0.f;
#pragma unroll 4
                    for (int c = 0; c < 16; ++c) { const h16x8 kv = *(const h16x8*)(kp + 8 * c); const h16x8 qv = *(const LAS h16x8*)(q_l + h * 128 + 8 * c);
#pragma unroll
                        for (int e = 0; e < 4; ++e) { h16x2 qa, ka; qa.x = qv[2 * e]; qa.y = qv[2 * e + 1]; ka.x = kv[2 * e]; ka.y = kv[2 * e + 1]; d = __builtin_amdgcn_fdot2(qa, ka, d, false); } }
                    lg[i][h] = valid ? d * scale : -INFINITY; }
            }
        }
#pragma unroll
        for (int h = 0; h < NH; ++h) {
            float mx = fmaxf(fmaxf(lg[0][h], lg[1][h]), fmaxf(lg[2][h], lg[3][h])); mx = wave_max(mx);
            float e[4], s = 0.f;
#pragma unroll
            for (int i = 0; i < 4; ++i) { e[i] = __expf(lg[i][h] - mx); s += e[i]; }
            s = wave_sum(s); const float inv = 1.0f / s;
#pragma unroll
            for (int i = 0; i < 4; ++i) p_l[(i * 64 + F.lane) * 8 + h] = e[i] * inv;
        }
        LDS_WAIT(); asm volatile("" ::: "memory");
        float o[NH][2];
#pragma unroll
        for (int h = 0; h < NH; ++h) { o[h][0] = 0.f; o[h][1] = 0.f; }
#pragma unroll 4
        for (int j = 0; j < nk; ++j) {
            const unsigned row = __builtin_amdgcn_readfirstlane(idx_l[j]);
            const f32x4 p0 = *(const LAS f32x4*)(p_l + j * 8), p1 = *(const LAS f32x4*)(p_l + j * 8 + 4);
            const float pp[8] = {p0[0], p0[1], p0[2], p0[3], p1[0], p1[1], p1[2], p1[3]};
            if (IS_A) { const h16x2 v = *(const h16x2*)(proj + (size_t)row * PROJ_LD + PC_AV + 2 * F.lane); const float v0 = (float)v.x, v1 = (float)v.y;
#pragma unroll
                for (int h = 0; h < NH; ++h) { o[h][0] += pp[h] * v0; o[h][1] += pp[h] * v1; } }
            else {
#pragma unroll
                for (int h = 0; h < NH; ++h) { const h16x2 v = *(const h16x2*)(memkv + (size_t)row * 4096 + 512 + h * 128 + 2 * F.lane); o[h][0] += pp[h] * (float)v.x; o[h][1] += pp[h] * (float)v.y; } }
        }
        half_t* op = ocat + (size_t)m * D + (IS_A ? 0 : 1536);
#pragma unroll
        for (int h = 0; h < NH; ++h) *(unsigned*)(op + h * 128 + 2 * F.lane) = pkh(o[h][0], o[h][1]);
        asm volatile("" ::: "memory");
    }
}

__device__ __forceinline__ void phase_battn(const Frame& F0, const half_t* qb, const half_t* kvb, const half_t* krope, const float* cs, half_t* ocat) {
    Frame F = F0; asm volatile("" : "+v"(F.lane)); asm volatile("" : "+v"(F.tid)); asm volatile("" : "+s"(F.wave));
    constexpr int KROW = 200;
    LAS half_t* k_l = (LAS half_t*)F.lds;
    LAS half_t* v_l = (LAS half_t*)(F.lds + 25600);
    LAS half_t* q_l = (LAS half_t*)(F.lds + 25600 + 16384) + F.wave * 192;
    const float scale = 0.07216878364870322f;
    const int ntask = BATCH * B_HEADS * (SEQ / 8);
    for (int task = blockIdx.x; task < ntask; task += F.G) {
        const int tt = (SEQ / 8 - 1) - task / (BATCH * B_HEADS); const int bh = task % (BATCH * B_HEADS); const int b = bh / B_HEADS, h = bh % B_HEADS;
        const int t = tt * 8 + F.wave, m = b * SEQ + t;
        { const half_t* qp = qb + (size_t)m * QB_LD + h * 192;
          for (int i = F.lane; i < 128; i += 64) q_l[i] = qp[i];
          if (F.lane < 32) { const float x1 = (float)qp[128 + F.lane], x2 = (float)qp[160 + F.lane]; const float c = cs[(size_t)m * 64 + F.lane], s = cs[(size_t)m * 64 + 32 + F.lane];
              q_l[128 + F.lane] = (half_t)(x1 * c - x2 * s); q_l[160 + F.lane] = (half_t)(x1 * s + x2 * c); } }
        float mx = -INFINITY, l = 0.f, o0 = 0.f, o1 = 0.f;
        const int nchunk = (tt * 8 + 8 + 63) / 64;
        for (int c = 0; c < nchunk; ++c) {
            __syncthreads();
            for (int i = F.tid; i < 64 * 24; i += NTHREADS) { const int r = i / 24, pc = i % 24; const int row = b * SEQ + c * 64 + r;
                const u32x4 v = (pc < 16) ? *(const u32x4*)(kvb + (size_t)row * KVB_LD + h * 256 + 8 * pc) : *(const u32x4*)(krope + (size_t)row * ROPE + 8 * (pc - 16));
                *(LAS u32x4*)(k_l + r * KROW + 8 * pc) = v; }
            for (int i = F.tid; i < 64 * 16; i += NTHREADS) { const int r = i / 16, pc = i % 16; const int row = b * SEQ + c * 64 + r;
                *(LAS u32x4*)(v_l + r * 128 + 8 * pc) = *(const u32x4*)(kvb + (size_t)row * KVB_LD + h * 256 + 128 + 8 * pc); }
            __syncthreads();
            const int s = c * 64 + F.lane; const bool valid = s <= t;
            float d = 0.f;
#pragma unroll 6
            for (int pc = 0; pc < 24; ++pc) { const h16x8 kv = *(const LAS h16x8*)(k_l + F.lane * KROW + 8 * pc); const h16x8 qv = *(const LAS h16x8*)(q_l + 8 * pc);
#pragma unroll
                for (int e = 0; e < 4; ++e) { h16x2 qa, ka; qa.x = qv[2 * e]; qa.y = qv[2 * e + 1]; ka.x = kv[2 * e]; ka.y = kv[2 * e + 1]; d = __builtin_amdgcn_fdot2(qa, ka, d, false); } }
            const float lgt = valid ? d * scale : -INFINITY;
            const float mn = fmaxf(mx, wave_max(lgt));
            const float corr = __expf(mx - mn); const float p = __expf(lgt - mn);
            l = l * corr + wave_sum(p); o0 *= corr; o1 *= corr; mx = mn;
#pragma unroll 8
            for (int j = 0; j < 64; ++j) { const float pj = __shfl(p, j); const h16x2 v = *(const LAS h16x2*)(v_l + j * 128 + 2 * F.lane); o0 += pj * (float)v.x; o1 += pj * (float)v.y; }
        }
        const float inv = 1.0f / l;
        *(unsigned*)(ocat + (size_t)m * D + 768 + h * 128 + 2 * F.lane) = pkh(o0 * inv, o1 * inv);
    }
    __syncthreads();
}

typedef float f32x16 __attribute__((ext_vector_type(16)));
typedef short s16x4v __attribute__((__vector_size__(4 * sizeof(short))));
__device__ __forceinline__ h16x4 lds_tr_read(LAS unsigned char* p) { s16x4v r = __builtin_amdgcn_ds_read_tr16_b64_v4i16((LAS s16x4v*)p); return __builtin_bit_cast(h16x4, r); }
struct AttnSrc {
    const half_t* q; int q_ld, q_hs;
    const half_t* k0; int k0_ld, k0_hs;
    const half_t* k1; int k1_ld;
    const half_t* v; int v_ld, v_hs;
    half_t* o; int o_ld, o_off;
    int nheads, kv_rows;
    float scale; const float* cs;
    const unsigned long long* selm; const int* pos; const float* relb; const int* lut;
    int rev;
};
template <int DQK, bool CAUSAL, int MODE>
__device__ __forceinline__ void phase_attn_mfma(const Frame& F0, const AttnSrc& T) {
    Frame F = F0; asm volatile("" : "+v"(F.lane)); asm volatile("" : "+v"(F.tid)); asm volatile("" : "+s"(F.wave));
    constexpr int NKS = DQK / 16, KROWB = (DQK == 192) ? 400 : 272, VROWB = 320, KBYTES = 64 * KROWB, VBYTES = 64 * VROWB, BUF = KBYTES + VBYTES + 256;
    constexpr int KPT = DQK / 64, VPT = 2;
    constexpr int BL_OFF = 2 * BUF;
    static_assert(2 * BUF + 1024 <= RING_BYTES, "attention LDS");
    const int lane = F.lane, hh = lane >> 5, l31 = lane & 31, wave = F.wave, tid = F.tid;
    int bid = T.rev ? (int)(gridDim.x - 1 - blockIdx.x) : (int)blockIdx.x; asm volatile("" : "+s"(bid));
    LAS unsigned char* lds = F.lds;
    const float c = T.scale * 1.4426950408889634f;
    const int nbh = BATCH * T.nheads, nunits = nbh * 8;
    const int sr = tid >> 3, sp0 = tid & 7;
    const int trofs = (4 * hh + ((lane & 15) >> 2)) * VROWB + (16 * ((lane >> 4) & 1) + 4 * (lane & 3)) * 2;
    const int kofs = l31 * KROWB + 16 * hh;
#pragma unroll 1
    for (int round = 0;; ++round) {
        int u;
        if (CAUSAL && F.G == 256 && nunits == 384) { if (round == 0) u = bid; else if (round == 1 && bid >= 128) u = 511 - bid; else break; }
        else { u = bid + round * F.G; if (u >= nunits) break; }
        const int qblk = CAUSAL ? 7 - u / nbh : u / nbh; const int bh = u % nbh; const int b = bh / T.nheads, h = bh % T.nheads;
        const int R0 = 256 * qblk + 32 * wave;
        const size_t mrow = (size_t)b * SEQ + R0 + l31;
        h16x8 qf[NKS];
        { const half_t* qp = T.q + mrow * T.q_ld + h * T.q_hs + 8 * hh;
#pragma unroll
          for (int ks = 0; ks < NKS; ++ks) qf[ks] = *(const h16x8*)(qp + 16 * ks); }
        if (DQK == 192) {
            const float* csr = T.cs + mrow * 64;
#pragma unroll
            for (int a = 0; a < 2; ++a)
#pragma unroll
                for (int j = 0; j < 8; ++j) { const int idx = 16 * a + 8 * hh + j; const float cv = csr[idx], sv = csr[32 + idx]; const float x1 = (float)qf[8 + a][j], x2 = (float)qf[10 + a][j];
                    qf[8 + a][j] = (half_t)(x1 * cv - x2 * sv); qf[10 + a][j] = (half_t)(x1 * sv + x2 * cv); }
        }
        f32x16 o[4];
#pragma unroll
        for (int dt = 0; dt < 4; ++dt)
#pragma unroll
            for (int r = 0; r < 16; ++r) o[dt][r] = 0.f;
        float mrun = -1e30f, lsum = 0.f;
        const int ntiles = CAUSAL ? 4 * (qblk + 1) : T.kv_rows / 64;
        const int my_last = CAUSAL ? 4 * qblk + (wave >> 1) : ntiles - 1;
        const size_t kvrow0 = (size_t)b * T.kv_rows;
        u32x4 kreg[KPT], vreg[VPT], preg;
        int posq = 0, posq_min = 0; unsigned long long wnext = 0ull; const unsigned long long* selrow = nullptr;
        if (MODE == 1) { posq = T.pos[mrow]; posq_min = posq;
#pragma unroll
            for (int of = 1; of < 64; of <<= 1) { const int other = xshfl_i(posq_min, of, lane); posq_min = other < posq_min ? other : posq_min; }
            selrow = T.selm + mrow * 32; wnext = selrow[0]; }
#define ATT_ISSUE(j) do { const size_t row = kvrow0 + 64 * (j) + sr; const half_t* pk0 = T.k0 + row * T.k0_ld + h * T.k0_hs + 8 * sp0; const half_t* pk1 = (DQK == 192) ? T.k1 + row * T.k1_ld + 8 * sp0 : pk0; \
            const half_t* pv = T.v + row * T.v_ld + h * T.v_hs + 8 * sp0; \
            _Pragma("unroll") for (int k = 0; k < KPT; ++k) kreg[k] = (k < 2) ? *(const u32x4*)(pk0 + 64 * k) : *(const u32x4*)(pk1); \
            _Pragma("unroll") for (int k = 0; k < VPT; ++k) vreg[k] = *(const u32x4*)(pv + 64 * k); \
            if (MODE == 1) preg = *(const u32x4*)(T.pos + kvrow0 + 64 * (j) + 4 * (tid & 15)); } while (0)
#define ATT_WRITE(buf) do { LAS unsigned char* wb = lds + (buf) * BUF + sp0 * 16; _Pragma("unroll") for (int k = 0; k < KPT; ++k) *(LAS u32x4*)(wb + sr * KROWB + k * 128) = kreg[k]; \
        _Pragma("unroll") for (int k = 0; k < VPT; ++k) *(LAS u32x4*)(wb + KBYTES + sr * VROWB + k * 128) = vreg[k]; \
        if (MODE == 1) { if (tid < 16) *(LAS u32x4*)(lds + (buf) * BUF + KBYTES + VBYTES + tid * 16) = preg; } } while (0)
        __syncthreads();
        if (MODE == 1) { if (tid <= 128) ((LAS float*)(lds + BL_OFF))[tid] = T.relb[T.lut[tid] * A_HEADS + h] * 1.4426950408889634f; }
        ATT_ISSUE(0); ATT_WRITE(0);
        __syncthreads();
        const float bl31 = (MODE == 1) ? ((const LAS float*)(lds + BL_OFF))[128] : 0.f;
#pragma unroll 1
        for (int j = 0; j < ntiles; ++j) {
            const int buf = j & 1;
            if (j + 1 < ntiles) ATT_ISSUE(j + 1);
            if (j <= my_last) {
                LAS unsigned char* kb = lds + buf * BUF;
                unsigned long long wsel = 0ull;
                if (MODE == 1) { wsel = wnext; if (j < my_last) wnext = selrow[j + 1]; }
                f32x16 s0, s1;
#pragma unroll
                for (int r = 0; r < 16; ++r) { s0[r] = 0.f; s1[r] = 0.f; }
                __builtin_amdgcn_s_setprio(1);
#pragma unroll
                for (int ks = 0; ks < NKS; ++ks) {
                    const h16x8 a0 = *(const LAS h16x8*)(kb + kofs + ks * 32), a1 = *(const LAS h16x8*)(kb + kofs + 32 * KROWB + ks * 32);
                    s0 = __builtin_amdgcn_mfma_f32_32x32x16_f16(a0, qf[ks], s0, 0, 0, 0);
                    s1 = __builtin_amdgcn_mfma_f32_32x32x16_f16(a1, qf[ks], s1, 0, 0, 0);
                }
                __builtin_amdgcn_s_setprio(0);
                if (MODE == 1) {
                    const LAS int* pk = (const LAS int*)(kb + KBYTES + VBYTES);
                    int pkmax = pk[lane];
#pragma unroll
                    for (int of = 1; of < 64; of <<= 1) { const int other = xshfl_i(pkmax, of, lane); pkmax = other > pkmax ? other : pkmax; }
                    if (posq_min - pkmax >= 128) {
#pragma unroll
                        for (int r = 0; r < 16; ++r) { s0[r] = s0[r] * c + bl31; s1[r] = s1[r] * c + bl31; }
                    } else {
                        const LAS float* bl = (const LAS float*)(lds + BL_OFF);
#pragma unroll
                        for (int g = 0; g < 4; ++g) {
                            const i32x4 pa = *(const LAS i32x4*)(pk + 8 * g + 4 * hh), pb = *(const LAS i32x4*)(pk + 32 + 8 * g + 4 * hh);
                            const int pav[4] = {pa[0], pa[1], pa[2], pa[3]}, pbv[4] = {pb[0], pb[1], pb[2], pb[3]};
#pragma unroll
                            for (int e = 0; e < 4; ++e) { int d0 = posq - pav[e]; d0 = d0 < 0 ? 0 : (d0 > 128 ? 128 : d0); int d1 = posq - pbv[e]; d1 = d1 < 0 ? 0 : (d1 > 128 ? 128 : d1);
                                s0[4 * g + e] = s0[4 * g + e] * c + bl[d0]; s1[4 * g + e] = s1[4 * g + e] * c + bl[d1]; }
                        }
                    }
                    const unsigned wl = (unsigned)(wsel >> (4 * hh)), wh = (unsigned)(wsel >> (32 + 4 * hh));
#pragma unroll
                    for (int r = 0; r < 16; ++r) { const unsigned bitc = 1u << (8 * (r >> 2) + (r & 3)); if (!(wl & bitc)) s0[r] = -INFINITY; if (!(wh & bitc)) s1[r] = -INFINITY; }
                } else {
#pragma unroll
                    for (int r = 0; r < 16; ++r) { s0[r] *= c; s1[r] *= c; }
                    if (CAUSAL && j == my_last) {
                        const int qi = R0 + l31, k0i = 64 * j + 4 * hh;
#pragma unroll
                        for (int r = 0; r < 16; ++r) { const int key = k0i + 8 * (r >> 2) + (r & 3); if (key > qi) s0[r] = -INFINITY; if (key + 32 > qi) s1[r] = -INFINITY; }
                    }
                }
                float mx = fmaxf(s0[0], s1[0]);
#pragma unroll
                for (int r = 1; r < 16; ++r) mx = fmaxf(mx, fmaxf(s0[r], s1[r]));
                mx = fmaxf(mx, xshfl_f(mx, 32, lane));
                if (!__all(mx <= mrun + 8.0f)) {
                    const float mnew = fmaxf(mrun, mx); const float alpha = __builtin_amdgcn_exp2f(mrun - mnew); mrun = mnew; lsum *= alpha;
#pragma unroll
                    for (int dt = 0; dt < 4; ++dt)
#pragma unroll
                        for (int r = 0; r < 16; ++r) o[dt][r] *= alpha;
                }
                float ps = 0.f;
#pragma unroll
                for (int r = 0; r < 16; ++r) { s0[r] = __builtin_amdgcn_exp2f(s0[r] - mrun); s1[r] = __builtin_amdgcn_exp2f(s1[r] - mrun); ps += s0[r] + s1[r]; }
                lsum += ps;
                h16x8 pf[4];
#pragma unroll
                for (int sp = 0; sp < 4; ++sp)
#pragma unroll
                    for (int j2 = 0; j2 < 8; ++j2) pf[sp][j2] = (half_t)((sp >> 1) ? s1[8 * (sp & 1) + j2] : s0[8 * (sp & 1) + j2]);
                LAS unsigned char* vb = kb + KBYTES + trofs;
                __builtin_amdgcn_s_setprio(1);
#pragma unroll
                for (int sp = 0; sp < 4; ++sp)
#pragma unroll
                    for (int dt = 0; dt < 4; ++dt) {
                        const h16x4 x = lds_tr_read(vb + sp * 16 * VROWB + dt * 64), y = lds_tr_read(vb + (sp * 16 + 8) * VROWB + dt * 64);
                        h16x8 av; av[0] = x[0]; av[1] = x[1]; av[2] = x[2]; av[3] = x[3]; av[4] = y[0]; av[5] = y[1]; av[6] = y[2]; av[7] = y[3];
                        o[dt] = __builtin_amdgcn_mfma_f32_32x32x16_f16(av, pf[sp], o[dt], 0, 0, 0);
                    }
                __builtin_amdgcn_s_setprio(0);
            }
            if (j + 1 < ntiles) ATT_WRITE(buf ^ 1);
            __syncthreads();
        }
#undef ATT_ISSUE
#undef ATT_WRITE
        const float ltot = lsum + xshfl_f(lsum, 32, lane); const float inv = 1.0f / ltot;
        half_t* op = T.o + mrow * T.o_ld + T.o_off + h * 128 + 4 * hh;
#pragma unroll
        for (int dt = 0; dt < 4; ++dt)
#pragma unroll
            for (int g = 0; g < 4; ++g) { u32x2 w; w.x = pkh(o[dt][4 * g] * inv, o[dt][4 * g + 1] * inv); w.y = pkh(o[dt][4 * g + 2] * inv, o[dt][4 * g + 3] * inv);
                *(u32x2*)(op + 32 * dt + 8 * g) = w; }
    }
    __syncthreads();
}

constexpr int NP = 13, NPH = 2 + DEPTH * NP;
#define P_X16 ((half_t*)ap->p[PX_X16])
#define P_PROJ ((half_t*)ap->p[PX_R1])
#define P_H16 ((half_t*)ap->p[PX_R1])
#define P_PRE16 ((half_t*)ap->p[PX_PRELN])
#define P_GSUM ((half_t*)ap->p[PX_GSUM])
#define P_OCAT ((half_t*)ap->p[PX_OCAT])
#define P_QB ((half_t*)ap->p[PX_QB])
#define P_KVB ((half_t*)ap->p[PX_KVB])
#define P_LATN ((half_t*)ap->p[PX_LATN])
#define P_KROPE ((half_t*)ap->p[PX_KROPE])
#define P_TMPF ((float*)ap->p[PX_TMPF])
#define P_SEL ((unsigned short*)ap->p[PX_SEL])
#define P_CS ((const float*)ap->p[PX_CS])
#define P_MEMKV ((half_t*)ap->p[PX_MEMKV])
#define P_LUT ((const int*)ap->p[PX_LUT])
#define P_LWP(k) ((const half_t*)ap->lw[l][k])
#define PH_NOINLINE static __device__ __attribute__((noinline))
static __device__ __forceinline__ void ph_prologue(CArgs* ap, int wv) { Frame F = make_frame(wv); F.ws = ap->ws; for (int rep = 0; rep < REP_PRO; ++rep) phase_prologue(F, ap); }
PH_NOINLINE void ph_ln(CArgs* ap, int l, int which, int wv) {
    Frame F = make_frame(wv); unsigned char* ws = ap->ws;
    for (int rep = 0; rep < REP_LN; ++rep) phase_ln(F, P_PRE16, (const float*)ap->in[4] + (size_t)(l * 3 + which) * D, (const float*)ap->in[5] + (size_t)(l * 3 + which) * D, P_X16, (l == DEPTH - 1 && which == 2) ? ap->out : nullptr);
}
PH_NOINLINE void ph_p5(CArgs* ap, int l, int wv) {
    Frame F = make_frame(wv); unsigned char* ws = ap->ws;
    phase_p5(F, P_PROJ, (const float*)ap->in[9] + (size_t)l * QL, (const float*)ap->in[10] + (size_t)l * KVL, P_LATN, P_KROPE, P_CS, P_SEL);
}
static __device__ __forceinline__ void ph_indexer(CArgs* ap, int wv) {
    Frame F = make_frame(wv); unsigned char* ws = ap->ws;
    for (int rep = 0; rep < REP_IDX; ++rep) phase_indexer(F, P_PROJ, P_SEL, (unsigned long long*)ap->p[PX_SELM]);
}
static __device__ __forceinline__ void ph_attn_a(CArgs* ap, int wv) {
    Frame F = make_frame(wv); unsigned char* ws = ap->ws;
    AttnSrc T; T.q = P_PROJ + PC_AQ; T.q_ld = PROJ_LD; T.q_hs = 128; T.k0 = P_PROJ + PC_AK; T.k0_ld = PROJ_LD; T.k0_hs = 0; T.k1 = nullptr; T.k1_ld = 0;
    T.v = P_PROJ + PC_AV; T.v_ld = PROJ_LD; T.v_hs = 0; T.o = P_OCAT; T.o_ld = D; T.o_off = 0; T.nheads = A_HEADS; T.kv_rows = SEQ; T.scale = 0.08838834764831845f; T.cs = nullptr;
    T.selm = (const unsigned long long*)ap->p[PX_SELM]; T.pos = (const int*)ap->in[2]; T.relb = (const float*)ap->in[3]; T.lut = P_LUT; T.rev = 0;
    phase_attn_mfma<128, true, 1>(F, T);
}
static __device__ __forceinline__ void ph_attn_c(CArgs* ap, int l, int wv) {
    Frame F = make_frame(wv); unsigned char* ws = ap->ws;
    AttnSrc T; T.q = P_PROJ + PC_CQ; T.q_ld = PROJ_LD; T.q_hs = 128; T.k0 = P_MEMKV + (size_t)l * 1024; T.k0_ld = 4096; T.k0_hs = 128; T.k1 = nullptr; T.k1_ld = 0;
    T.v = P_MEMKV + (size_t)l * 1024 + 512; T.v_ld = 4096; T.v_hs = 128; T.o = P_OCAT; T.o_ld = D; T.o_off = 1536; T.nheads = C_HEADS; T.kv_rows = MEML; T.scale = 0.08838834764831845f; T.cs = nullptr;
    T.selm = nullptr; T.pos = nullptr; T.relb = nullptr; T.lut = nullptr; T.rev = 0;
    phase_attn_mfma<128, false, 0>(F, T);
}
static __device__ __forceinline__ void ph_attn_b(CArgs* ap, int wv) {
    Frame F = make_frame(wv); unsigned char* ws = ap->ws;
    AttnSrc T; T.q = P_QB; T.q_ld = QB_LD; T.q_hs = 192; T.k0 = P_KVB; T.k0_ld = KVB_LD; T.k0_hs = 256; T.k1 = P_KROPE; T.k1_ld = ROPE;
    T.v = P_KVB + 128; T.v_ld = KVB_LD; T.v_hs = 256; T.o = P_OCAT; T.o_ld = D; T.o_off = 768; T.nheads = B_HEADS; T.kv_rows = SEQ; T.scale = 0.07216878364870322f; T.cs = P_CS;
    T.selm = nullptr; T.pos = nullptr; T.relb = nullptr; T.lut = nullptr; T.rev = 1;
    for (int rep = 0; rep < REP_BA; ++rep) phase_attn_mfma<192, true, 0>(F, T);
}
#define SITE_PTRS() CArgs* ap = kap; asm volatile("" : "+s"(ap)); unsigned char* ws = ap->ws; (void)ws
__global__ void __launch_bounds__(NTHREADS, 2) fwd_kernel(Args args) {
    extern __shared__ __attribute__((aligned(16))) unsigned char lds_raw[];
    CArgs* kap = (CArgs*)__builtin_amdgcn_kernarg_segment_ptr();
    LAS unsigned char* const lds = (LAS unsigned char*)lds_raw;
    const int G = gridDim.x;
    const int wv = __builtin_amdgcn_readfirstlane((int)threadIdx.x >> 6);
    int wv0_ = wv; asm volatile("" : "+s"(wv0_)); const int tid0 = wv0_ * 64 + lane_id();
    volatile LAS unsigned* ctl_l = (volatile LAS unsigned*)(lds + LDSCTL_OFF);
    for (int u = tid0; u < (LDS_BYTES - LDSCTL_OFF) / 4; u += NTHREADS) ctl_l[u] = 0u;
    __syncthreads();
    const int lo = args.ph_lo, hi = args.ph_hi;
    XcdBarrier bar; bar.bar = (unsigned*)(args.ws + WS_CTL) + CW_BAR; bar.x = 0; bar.st = ctl_l + 8; bar.wave = wv;
    if (hi - lo > 1) {
        bar = xcd_barrier_post((unsigned*)(args.ws + WS_CTL) + CW_BAR, ctl_l + 8, wv);
        if (tid0 == 0) { unsigned nloc, nx; xcd_barrier_complete(bar.bar, bar.x, nloc, nx); bar.st[0] = nloc; bar.st[1] = nx; }
        __syncthreads();
    }
#define IN(k) (lo <= (k) && (k) < hi)
#define SEAM(k) do { if (IN((k) + 1)) xcd_barrier(bar); } while (0)

    if (IN(0)) { SITE_PTRS(); ph_prologue(ap, wv); SEAM(0); }
    if (IN(1)) {
        SITE_PTRS();
        pg8::Gemm g{(const half_t*)ap->p[PX_MEM16], (const half_t*)ap->p[PX_WMEM], D, D, D}; pg8::StaticOrder S; S.init(BATCH * MEML, 4096, G, (int)blockIdx.x);
        pg8::EpiH16 E; E.O = P_MEMKV; E.ldc = 4096; E.sig_from = 1 << 30;
        pg8::gemm_phase(lds, g, S, E, wv);
        SEAM(1);
    }
#pragma unroll 1
    for (int l = 0; l < DEPTH; ++l) {
        const int p0 = 2 + l * NP;
        if (p0 + NP <= lo || p0 >= hi) continue;
        if (IN(p0 + 0)) {
            SITE_PTRS();
            pg8::Gemm g{P_X16, P_LWP(LWX_UP1), D, D, D}; pg8::StaticOrder S; S.init(M, 2 * DFF, G, (int)blockIdx.x);
            pg8::EpiSwiglu E; E.H = P_H16; E.ldh = DFF;
            for (int rep = 0; rep < REP_UP; ++rep) pg8::gemm_phase(lds, g, S, E, wv);
            SEAM(p0 + 0);
        }
        if (IN(p0 + 1)) {
            SITE_PTRS();
            pg8::Gemm g{P_H16, P_LWP(LWX_DN1), DFF, DFF, DFF}; pg8::StaticOrder S; S.init(M, D, G, (int)blockIdx.x);
            pg8::EpiResid16 E; E.X = P_X16; E.O = P_PRE16; E.alpha = ALPHA; E.coef = 0.5f;
            pg8::gemm_phase(lds, g, S, E, wv); SEAM(p0 + 1);
        }
        if (IN(p0 + 2)) { ph_ln(kap, l, 0, wv); SEAM(p0 + 2); }
        if (IN(p0 + 3)) {
            SITE_PTRS();
            pg8::Gemm g{P_X16, P_LWP(LWX_IN), D, D, D}; pg8::StaticOrder S; S.init(M, PROJ_LD, G, (int)blockIdx.x);
            pg8::EpiH16 E; E.O = P_PROJ; E.ldc = PROJ_LD; E.sig_from = PC_GATES / 256;
            pg8::gemm_phase(lds, g, S, E, wv); SEAM(p0 + 3);
        }
        if (IN(p0 + 4)) { ph_p5(kap, l, wv); { SITE_PTRS(); ph_indexer(ap, wv); } SEAM(p0 + 4); }
        if (IN(p0 + 5)) {
            { SITE_PTRS(); pg8::Gemm g{P_LATN, P_LWP(LWX_UQ), LATN_LD, QL, QL}; pg8::StaticOrder S; S.init(M, QB_LD, G, (int)blockIdx.x);
              pg8::EpiH16 E; E.O = P_QB; E.ldc = QB_LD; E.sig_from = 1 << 30; pg8::gemm_phase(lds, g, S, E, wv); }
            { SITE_PTRS(); pg8::Gemm g{P_LATN + 512, P_LWP(LWX_UKV), LATN_LD, KVL, KVL}; pg8::StaticOrder S; S.init(M, KVB_LD, G, (int)blockIdx.x);
              pg8::EpiH16 E; E.O = P_KVB; E.ldc = KVB_LD; E.sig_from = 1 << 30; pg8::gemm_phase(lds, g, S, E, wv); }
            SEAM(p0 + 5);
        }
        if (IN(p0 + 6)) {
            { SITE_PTRS(); ph_attn_a(ap, wv); } { SITE_PTRS(); ph_attn_c(ap, l, wv); } { SITE_PTRS(); ph_attn_b(ap, wv); }
            SEAM(p0 + 6);
        }
        if (IN(p0 + 7)) {
            SITE_PTRS(); pg8::Gemm g{P_OCAT, P_LWP(LWX_BR), D, D, D}; pg8::StaticOrder S; S.init(M, D, G, (int)blockIdx.x);
            pg8::EpiGate E; E.G = P_PROJ + PC_GATES; E.ldg = PROJ_LD; E.O = P_GSUM; E.t1 = 768 / 64; E.t2 = 1536 / 64;
            pg8::gemm_phase(lds, g, S, E, wv);
            SEAM(p0 + 7);
        }
        if (IN(p0 + 8)) {
            SITE_PTRS();
            pg8::Gemm g{P_GSUM, P_LWP(LWX_OUT), D, D, D}; pg8::StaticOrder S; S.init(M, D, G, (int)blockIdx.x);
            pg8::EpiResid16 E; E.X = P_X16; E.O = P_PRE16; E.alpha = ALPHA; E.coef = 1.0f;
            pg8::gemm_phase(lds, g, S, E, wv); SEAM(p0 + 8);
        }
        if (IN(p0 + 9)) { ph_ln(kap, l, 1, wv); SEAM(p0 + 9); }
        if (IN(p0 + 10)) {
            SITE_PTRS();
            pg8::Gemm g{P_X16, P_LWP(LWX_UP2), D, D, D}; pg8::StaticOrder S; S.init(M, 2 * DFF, G, (int)blockIdx.x);
            pg8::EpiSwiglu E; E.H = P_H16; E.ldh = DFF;
            for (int rep = 0; rep < REP_UP; ++rep) pg8::gemm_phase(lds, g, S, E, wv);
            SEAM(p0 + 10);
        }
        if (IN(p0 + 11)) {
            SITE_PTRS();
            pg8::Gemm g{P_H16, P_LWP(LWX_DN2), DFF, DFF, DFF}; pg8::StaticOrder S; S.init(M, D, G, (int)blockIdx.x);
            pg8::EpiResid16 E; E.X = P_X16; E.O = P_PRE16; E.alpha = ALPHA; E.coef = 0.5f;
            pg8::gemm_phase(lds, g, S, E, wv); SEAM(p0 + 11);
        }
        if (IN(p0 + 12)) { ph_ln(kap, l, 2, wv); SEAM(p0 + 12); }
    }
#undef IN
#undef SEAM
}

extern "C" void kernel_launch(void* const* d_in, const int* in_sizes, int n_in, void* d_out, int out_size, void* d_ws, size_t ws_size, hipStream_t stream) {
    static int grid = 0;
    if (grid == 0) {
        if (n_in != 18 || out_size != M * D || ws_size < WS_END) { fprintf(stderr, "kernel_launch: unexpected shapes (n_in %d out %d ws %zu need %zu)\n", n_in, out_size, ws_size, (size_t)WS_END); grid = -1; return; }
        int dev = 0, cus = 0, per_cu = 0;
        if (hipGetDevice(&dev) != hipSuccess || hipDeviceGetAttribute(&cus, hipDeviceAttributeMultiprocessorCount, dev) != hipSuccess) { grid = -1; return; }
        if (hipFuncSetAttribute((const void*)fwd_kernel, hipFuncAttributeMaxDynamicSharedMemorySize, LDS_BYTES) != hipSuccess) { fprintf(stderr, "kernel_launch: hipFuncSetAttribute failed\n"); grid = -1; return; }
        if (hipOccupancyMaxActiveBlocksPerMultiprocessor(&per_cu, (const void*)fwd_kernel, NTHREADS, LDS_BYTES) != hipSuccess || per_cu < 1) { fprintf(stderr, "kernel_launch: occupancy query says %d\n", per_cu); }
        (void)hipGetLastError();
        grid = cus;
    }
    if (grid < 0) return;
    (void)hipMemsetAsync((char*)d_ws + WS_CTL, 0, CTL_ZERO_BYTES, stream);
    Args a{};
    for (int i = 0; i < 18; ++i) a.in[i] = d_in[i];
    a.out = (float*)d_out; a.ws = (unsigned char*)d_ws;
    { unsigned char* w = (unsigned char*)d_ws;
      a.p[PX_X16] = w + WS_X16; a.p[PX_R1] = w + WS_R1; a.p[PX_PRELN] = w + WS_R1 + R1_PRELN; a.p[PX_OCAT] = w + WS_OCAT; a.p[PX_QB] = w + WS_QB; a.p[PX_KVB] = w + WS_KVB; a.p[PX_LATN] = w + WS_LATN;
      a.p[PX_KROPE] = w + WS_KROPE; a.p[PX_TMPF] = w + WS_TMP; a.p[PX_SEL] = w + WS_SEL; a.p[PX_CS] = w + WS_CS; a.p[PX_MEMKV] = w + WS_MEMKV; a.p[PX_LUT] = w + WS_LUT; a.p[PX_SELM] = w + WS_SELM;
      a.p[PX_MEM16] = w + WS_MEM16; a.p[PX_WMEM] = w + WS_WMEM; a.p[PX_GSUM] = w + WS_GSUM;
      const size_t lwo[LWX_N] = {LW_UP1, LW_DN1, LW_IN, LW_UQ, LW_UKV, LW_BR, LW_OUT, LW_UP2, LW_DN2};
      for (int l = 0; l < DEPTH; ++l) for (int k = 0; k < LWX_N; ++k) a.lw[l][k] = w + WS_W + (size_t)l * LW_END + lwo[k]; }
#if ONE_LAUNCH
    a.ph_lo = 0; a.ph_hi = NPH;
    hipLaunchKernelGGL(fwd_kernel, dim3(grid), dim3(NTHREADS), LDS_BYTES, stream, a);
#else
    for (int p = 0; p < NPH; ++p) { a.ph_lo = p; a.ph_hi = p + 1; hipLaunchKernelGGL(fwd_kernel, dim3(grid), dim3(NTHREADS), LDS_BYTES, stream, a); }
#endif
}
```
